# Optimizing an MI355X kernel written in HIP

```python
import jax, jax.numpy as jnp
from jax import lax
import numpy as np


D_MODEL = 1024
BATCH = 8
SEQ = 4096
DEPTH = 4

N_MIXERS = 3
POOL_WINDOWS = (2, 4, 8, 16)
POOL_GROUPS = len(POOL_WINDOWS)
POOL_GROUP_DIM = D_MODEL // POOL_GROUPS
SGU_CHUNK = 128
SGU_WIDTH = D_MODEL
SGU_HEAD_DIM = 128
SGU_HEADS = SGU_WIDTH // SGU_HEAD_DIM
MLA_HEADS = 16
MLA_Q_LORA = 256
MLA_KV_LORA = 128
MLA_NOPE = 128
MLA_ROPE = 64
MLA_V = 128
ROPE_THETA = 10000.0
Q_BLOCK = 128
D_FF = 4 * D_MODEL
RMS_EPS = 1e-6
LN_EPS = 1e-5
MAX_POS_OFFSET = 4096
N_POOL_LAYERS = len(range(0, DEPTH, N_MIXERS))
N_SGU_LAYERS = len(range(1, DEPTH, N_MIXERS))
N_MLA_LAYERS = len(range(2, DEPTH, N_MIXERS))

kernel_name = 'hybrid_pool_sgu_mla_decoder'


def rmsnorm(x, g):
    xf = x.astype(jnp.float32)
    y = xf * lax.rsqrt(jnp.mean(xf * xf, axis=-1, keepdims=True) + RMS_EPS)
    return (y * g.astype(jnp.float32)).astype(x.dtype)


def layernorm(x, g, b):
    xf = x.astype(jnp.float32)
    mu = jnp.mean(xf, axis=-1, keepdims=True)
    xc = xf - mu
    var = jnp.mean(xc * xc, axis=-1, keepdims=True)
    y = xc * lax.rsqrt(var + LN_EPS)
    return (y * g.astype(jnp.float32) + b.astype(jnp.float32)).astype(x.dtype)


def modulate(h, shift, scale):
    return h * (1.0 + scale[:, None, :]) + shift[:, None, :]


def pool_mixer(h, w, scale):
    B_, S_, _ = h.shape
    hf = h.astype(jnp.float32).reshape(B_, S_, POOL_GROUPS, POOL_GROUP_DIM)
    cs = jnp.cumsum(hf, axis=1)
    cs = jnp.concatenate([jnp.zeros_like(cs[:, :1]), cs], axis=1)
    t = jnp.arange(S_, dtype=jnp.float32)
    outs = []
    for gi, win in enumerate(POOL_WINDOWS):
        csg = cs[:, :, gi]
        upper = csg[:, 1:]
        lower = jnp.concatenate([jnp.zeros_like(csg[:, :win - 1]), csg[:, :S_ - win + 1]], axis=1)
        count = jnp.minimum(t + 1.0, float(win))[None, :, None]
        outs.append((upper - lower) / count - hf[:, :, gi])
    pooled = jnp.stack(outs, axis=2).astype(h.dtype)
    y = jnp.einsum('bsgc,gcd->bsgd', pooled, w).reshape(B_, S_, D_MODEL)
    return y * scale


def sgu_mixer(h, w_in, ln_g, ln_b, w_s, b_s, w_out):
    B_, S_, _ = h.shape
    z = jax.nn.gelu(h @ w_in, approximate=False)
    u, v = jnp.split(z, 2, axis=-1)
    v = layernorm(v, ln_g, ln_b)
    nc = S_ // SGU_CHUNK
    v = v.reshape(B_, nc, SGU_CHUNK, SGU_HEADS, SGU_HEAD_DIM)
    mask = jnp.tril(jnp.ones((SGU_CHUNK, SGU_CHUNK), dtype=bool))
    ws = jnp.where(mask[None], w_s, 0)
    mixed = jnp.einsum('hts,bnshc->bnthc', ws, v) + b_s.T[None, None, :, :, None]
    gated = u * mixed.reshape(B_, S_, SGU_WIDTH)
    return gated @ w_out


def apply_rope(x, cos, sin):
    x1, x2 = jnp.split(x, 2, axis=-1)
    return jnp.concatenate([x1 * cos - x2 * sin, x2 * cos + x1 * sin], axis=-1)


def mla_mixer(h, positions, w_dq_dkv, q_norm_g, kv_norm_g, w_uq, w_ukv, w_o):
    B_, S_, _ = h.shape
    lat = h @ w_dq_dkv
    c_q, c_kv, k_rope = jnp.split(lat, [MLA_Q_LORA, MLA_Q_LORA + MLA_KV_LORA], axis=-1)
    c_q = rmsnorm(c_q, q_norm_g)
    c_kv = rmsnorm(c_kv, kv_norm_g)
    q = (c_q @ w_uq).reshape(B_, S_, MLA_HEADS, MLA_NOPE + MLA_ROPE)
    q_nope, q_rope = jnp.split(q, [MLA_NOPE], axis=-1)
    kv = (c_kv @ w_ukv).reshape(B_, S_, MLA_HEADS, MLA_NOPE + MLA_V)
    k_nope, v = jnp.split(kv, [MLA_NOPE], axis=-1)
    inv_freq = ROPE_THETA ** (-jnp.arange(0, MLA_ROPE, 2, dtype=jnp.float32) / MLA_ROPE)
    ang = positions.astype(jnp.float32)[..., None] * inv_freq
    cos, sin = jnp.cos(ang), jnp.sin(ang)
    q_rope = apply_rope(q_rope.astype(jnp.float32), cos[:, :, None], sin[:, :, None]).astype(h.dtype)
    k_rope = apply_rope(k_rope.astype(jnp.float32), cos, sin).astype(h.dtype)
    sm_scale = (MLA_NOPE + MLA_ROPE) ** -0.5
    nb = S_ // Q_BLOCK

    def to_blocks(t):
        return jnp.moveaxis(t.reshape(B_, nb, Q_BLOCK, *t.shape[2:]), 1, 0)

    k_idx = jnp.arange(S_)

    def attend_block(args):
        qn, qr, blk = args
        s = jnp.einsum('bqhd,bkhd->bhqk', qn, k_nope, preferred_element_type=jnp.float32)
        s = s + jnp.einsum('bqhr,bkr->bhqk', qr, k_rope, preferred_element_type=jnp.float32)
        q_idx = blk * Q_BLOCK + jnp.arange(Q_BLOCK)
        causal = k_idx[None, :] <= q_idx[:, None]
        s = jnp.where(causal[None, None], s * sm_scale, -1e30)
        p = jax.nn.softmax(s, axis=-1).astype(v.dtype)
        return jnp.einsum('bhqk,bkhd->bqhd', p, v)

    out = lax.map(attend_block, (to_blocks(q_nope), to_blocks(q_rope), jnp.arange(nb)))
    out = jnp.moveaxis(out, 0, 1).reshape(B_, S_, MLA_HEADS * MLA_V)
    return out @ w_o


def sq_relu_mlp(h, w1, w2):
    return jnp.square(jax.nn.relu(h @ w1)) @ w2


def setup_inputs(seed: int = 0) -> dict:
    key = jax.random.key(seed)
    ks = jax.random.split(key, 32)
    f32 = jnp.float32

    def nrm(k, shape, std):
        return jax.random.normal(k, shape, f32) * std

    def gain(k, shape):
        return 1.0 + 0.1 * jax.random.normal(k, shape, f32)

    x = jax.random.normal(ks[0], (BATCH, SEQ, D_MODEL), f32)
    c = jax.random.normal(ks[1], (BATCH, D_MODEL), f32)
    offset = jax.random.randint(ks[2], (BATCH, 1), 0, MAX_POS_OFFSET, dtype=jnp.int32)
    positions = (offset + jnp.arange(SEQ, dtype=jnp.int32)[None, :]).astype(jnp.int32)
    return {
        'x': x,
        'c': c,
        'positions': positions,
        'ada_w': nrm(ks[3], (DEPTH, D_MODEL, 6 * D_MODEL), 0.5 * D_MODEL ** -0.5),
        'ada_b': nrm(ks[4], (DEPTH, 6 * D_MODEL), 0.02),
        'norm_mix_g': gain(ks[5], (DEPTH, D_MODEL)),
        'norm_mlp_g': gain(ks[6], (DEPTH, D_MODEL)),
        'pool_w': nrm(ks[7], (N_POOL_LAYERS, POOL_GROUPS, POOL_GROUP_DIM, POOL_GROUP_DIM), POOL_GROUP_DIM ** -0.5),
        'pool_scale': gain(ks[8], (N_POOL_LAYERS, D_MODEL)),
        'sgu_w_in': nrm(ks[9], (N_SGU_LAYERS, D_MODEL, 2 * SGU_WIDTH), D_MODEL ** -0.5),
        'sgu_ln_g': gain(ks[10], (N_SGU_LAYERS, SGU_WIDTH)),
        'sgu_ln_b': nrm(ks[11], (N_SGU_LAYERS, SGU_WIDTH), 0.02),
        'sgu_w_s': nrm(ks[12], (N_SGU_LAYERS, SGU_HEADS, SGU_CHUNK, SGU_CHUNK), SGU_CHUNK ** -0.5),
        'sgu_b_s': gain(ks[13], (N_SGU_LAYERS, SGU_HEADS, SGU_CHUNK)),
        'sgu_w_out': nrm(ks[14], (N_SGU_LAYERS, SGU_WIDTH, D_MODEL), SGU_WIDTH ** -0.5),
        'mla_w_dq_dkv': nrm(ks[15], (N_MLA_LAYERS, D_MODEL, MLA_Q_LORA + MLA_KV_LORA + MLA_ROPE), D_MODEL ** -0.5),
        'mla_q_norm_g': gain(ks[16], (N_MLA_LAYERS, MLA_Q_LORA)),
        'mla_kv_norm_g': gain(ks[17], (N_MLA_LAYERS, MLA_KV_LORA)),
        'mla_w_uq': nrm(ks[18], (N_MLA_LAYERS, MLA_Q_LORA, MLA_HEADS * (MLA_NOPE + MLA_ROPE)), MLA_Q_LORA ** -0.5),
        'mla_w_ukv': nrm(ks[19], (N_MLA_LAYERS, MLA_KV_LORA, MLA_HEADS * (MLA_NOPE + MLA_V)), MLA_KV_LORA ** -0.5),
        'mla_w_o': nrm(ks[20], (N_MLA_LAYERS, MLA_HEADS * MLA_V, D_MODEL), (MLA_HEADS * MLA_V) ** -0.5),
        'mlp_w1': nrm(ks[21], (DEPTH, D_MODEL, D_FF), D_MODEL ** -0.5),
        'mlp_w2': nrm(ks[22], (DEPTH, D_FF, D_MODEL), D_FF ** -0.5),
        'final_g': gain(ks[23], (D_MODEL,)),
    }


def reference(x, c, positions, ada_w, ada_b, norm_mix_g, norm_mlp_g, pool_w, pool_scale,
              sgu_w_in, sgu_ln_g, sgu_ln_b, sgu_w_s, sgu_b_s, sgu_w_out,
              mla_w_dq_dkv, mla_q_norm_g, mla_kv_norm_g, mla_w_uq, mla_w_ukv, mla_w_o,
              mlp_w1, mlp_w2, final_g):
    c_act = jax.nn.silu(c)
    for i in range(DEPTH):
        mod = c_act @ ada_w[i] + ada_b[i]
        sh1, sc1, g1, sh2, sc2, g2 = jnp.split(mod, 6, axis=-1)
        h = modulate(rmsnorm(x, norm_mix_g[i]), sh1, sc1)
        kind, j = i % N_MIXERS, i // N_MIXERS
        if kind == 0:
            y = pool_mixer(h, pool_w[j], pool_scale[j])
        elif kind == 1:
            y = sgu_mixer(h, sgu_w_in[j], sgu_ln_g[j], sgu_ln_b[j], sgu_w_s[j], sgu_b_s[j], sgu_w_out[j])
        else:
            y = mla_mixer(h, positions, mla_w_dq_dkv[j], mla_q_norm_g[j], mla_kv_norm_g[j],
                          mla_w_uq[j], mla_w_ukv[j], mla_w_o[j])
        x = x + g1[:, None, :] * y
        h = modulate(rmsnorm(x, norm_mlp_g[i]), sh2, sc2)
        x = x + g2[:, None, :] * sq_relu_mlp(h, mlp_w1[i], mlp_w2[i])
    return rmsnorm(x, final_g)
```

```cpp
#include <hip/hip_runtime.h>
#include <hip/hip_cooperative_groups.h>
#include <cstdio>
#include <cstdint>
#include <cstddef>
namespace cg = cooperative_groups;

#define LAS __attribute__((address_space(3)))
typedef unsigned short bf16_t;
typedef short bf16x8 __attribute__((ext_vector_type(8)));
typedef float f32x4 __attribute__((ext_vector_type(4)));
typedef float f32x2 __attribute__((ext_vector_type(2)));
typedef float f32x16 __attribute__((ext_vector_type(16)));
typedef unsigned u32x4 __attribute__((ext_vector_type(4)));
typedef unsigned u32x2 __attribute__((ext_vector_type(2)));

constexpr int BATCH = 8, SEQ = 4096, DM = 1024, FF = 4096, M = BATCH * SEQ, DEPTH = 4;
constexpr int MODW = 6 * DM;
constexpr float RMS_EPS = 1e-6f, LN_EPS = 1e-5f;
constexpr int NTHREADS = 512, NWAVES = 8;
constexpr int LDS_BYTES = 147456;

constexpr size_t MiB = 1u << 20;
constexpr size_t OFF_MOD = 0;
constexpr size_t OFF_BAR = 896 * 1024;
constexpr size_t OFF_CS = 1 * MiB;
constexpr size_t OFF_W1T = 9 * MiB;
constexpr size_t OFF_W2T = 41 * MiB;
constexpr size_t OFF_SGUIN = 73 * MiB;
constexpr size_t OFF_SGUOUT = 77 * MiB;
constexpr size_t OFF_WSB = 79 * MiB;
constexpr size_t OFF_LATT = 80 * MiB;
constexpr size_t OFF_QABS = 81 * MiB;
constexpr size_t OFF_OABS = 83 * MiB;
constexpr size_t OFF_POOLT = 87 * MiB;
constexpr size_t OFF_CQ = 88 * MiB;
constexpr size_t OFF_KK = 104 * MiB;
constexpr size_t OFF_VT = 116 * MiB;
constexpr size_t OFF_BIG = 128 * MiB;
constexpr size_t OFF_LAT = OFF_BIG + 6144;
constexpr int QPITCH = 4096, LATPITCH = 2048;
constexpr size_t OFF_H = 384 * MiB;
constexpr size_t OFF_OL = OFF_BIG + 192 * MiB;
constexpr size_t OFF_XB = 448 * MiB;
constexpr size_t WS_NEED = 512 * MiB;

__device__ __forceinline__ unsigned cvt_pk_bf16(float lo, float hi) { unsigned r; asm volatile("v_cvt_pk_bf16_f32 %0, %1, %2" : "=v"(r) : "v"(lo), "v"(hi)); return r; }
typedef __bf16 bf16x2_t __attribute__((ext_vector_type(2)));
__device__ __forceinline__ unsigned cvtpk_s(float lo, float hi) { f32x2 v = {lo, hi}; bf16x2_t b = __builtin_convertvector(v, bf16x2_t); return __builtin_bit_cast(unsigned, b); }
__device__ __forceinline__ float bf2f(unsigned short u) { return __uint_as_float(((unsigned)u) << 16); }
__device__ __forceinline__ float bflo(unsigned u) { return __uint_as_float(u << 16); }
__device__ __forceinline__ float bfhi(unsigned u) { return __uint_as_float(u & 0xffff0000u); }
__device__ __forceinline__ float shfl_x(float v, int lane, int o) { return __int_as_float(__builtin_amdgcn_ds_bpermute((lane ^ o) << 2, __float_as_int(v))); }
__device__ __forceinline__ float wave_sum(float v, int lane) {
#pragma unroll
    for (int o = 1; o < 64; o <<= 1) v += shfl_x(v, lane, o);
    return v;
}
__device__ __forceinline__ int fresh_s(int v) { asm volatile("" : "+s"(v)); return v; }

__device__ __forceinline__ int fresh_tid() { int t = threadIdx.x; asm volatile("" : "+v"(t)); return t; }
template <bool XF32> __device__ __forceinline__ f32x4 ldx4(const void* base, size_t i4) {
    if constexpr (XF32) return ((const f32x4*)base)[i4];
    else { const u32x2 r = ((const u32x2*)base)[i4]; return (f32x4){bflo(r.x), bfhi(r.x), bflo(r.y), bfhi(r.y)}; }
}
template <bool XF32> __device__ __forceinline__ f32x2 ldx2(const void* base, size_t i2) {
    if constexpr (XF32) return ((const f32x2*)base)[i2];
    else { const unsigned r = ((const unsigned*)base)[i2]; return (f32x2){bflo(r), bfhi(r)}; }
}
namespace pg8 {
constexpr int BM = 256, BK = 64, HALF = 128, HTB = HALF * BK * 2, STAGE_BYTES = 8 * HTB, NXCD = 8, WGM = 8;
__host__ __device__ __forceinline__ int lds_byte(int r, int c) { const int st = (r >> 4) * 2 + (c >> 5), rr = r & 15, cc = c & 31, ob = rr * 64 + cc * 2; return st * 1024 + (ob ^ (((ob >> 9) & 1) << 5)); }
__host__ __device__ __forceinline__ void stage_rc(int b, int& R, int& C) { const int st = b / 1024, sb = b % 1024, swz = sb ^ (((sb >> 9) & 1) << 5); R = (st >> 1) * 16 + swz / 64; C = (st & 1) * 32 + (swz % 64) / 2; }
__host__ __device__ __forceinline__ int perm32(int rho) { const int n = rho >> 4, i = rho & 15; return 8 * (i >> 2) + 4 * n + (i & 3); }

struct Unit { int pm, pn; };
struct Gemm { const bf16_t* A; const bf16_t* Bt; };

struct StaticOrder {
    int nM, nN, nwg, G, c, pmx = 0;
    __device__ void init(int M_, int N_, int G_, int c_) { nM = M_ / BM; nN = N_ / BM; nwg = nM * nN; G = G_; c = c_; }
    __device__ bool next(int i, Unit& u) const {
        const long L = (long)i * G + c; if (L >= nwg) return false;
        int wgid = (int)L; { const int q = nwg / NXCD, r = nwg % NXCD, xcd = wgid % NXCD, off = wgid / NXCD; wgid = (xcd < r ? xcd * (q + 1) : r * (q + 1) + (xcd - r) * q) + off; }
        const int nig = WGM * nN, gid = wgid / nig, fm = gid * WGM, gsz = (nM - fm) < WGM ? (nM - fm) : WGM;
        u.pm = (fm + ((wgid % nig) % gsz)) ^ pmx; u.pn = (wgid % nig) / gsz; return true;
    }
};

__device__ __forceinline__ f32x2 gelu_pk(f32x2 v) {
    const f32x2 av = __builtin_elementwise_abs(v), d = av * 0.2316418882f + 1.0f;
    f32x2 t; t.x = __builtin_amdgcn_rcpf(d.x); t.y = __builtin_amdgcn_rcpf(d.y);
    f32x2 q = t * 0.5307027145f + (-0.7265760135f); q = q * t + 0.7107068705f; q = q * t + (-0.142248368f); q = q * t + 0.127414796f; q = q * t;
    const f32x2 s = (v * v) * (-0.72134752044f);
    f32x2 e; e.x = __builtin_amdgcn_exp2f(s.x); e.y = __builtin_amdgcn_exp2f(s.y);
    const f32x2 m = v * (q * e), r = v - m;
    f32x2 o; o.x = v.x < 0.f ? m.x : r.x; o.y = v.y < 0.f ? m.y : r.y; return o;
}

template <int ACT  > struct EpiBf16 {
    static constexpr bool PERM = true;
    bf16_t* O; int ldc;
    __device__ __forceinline__ void operator()(const f32x4 (&acc)[2][2][4][2], const Unit& u, int wr, int wc, int fr, int fq) const {
        const int row0 = u.pm * BM + wr * 64 + fr; const int col0 = u.pn * BM + wc * 32 + 8 * fq;
#pragma unroll
        for (int ai = 0; ai < 2; ++ai)
#pragma unroll
            for (int m = 0; m < 4; ++m) { bf16_t* rowp = O + (size_t)(row0 + ai * HALF + m * 16) * ldc + col0;
#pragma unroll
                for (int bj = 0; bj < 2; ++bj) { f32x4 v0 = acc[ai][bj][m][0], v1 = acc[ai][bj][m][1];
                    if (ACT == 1) { f32x2 a = gelu_pk((f32x2){v0[0], v0[1]}), b = gelu_pk((f32x2){v0[2], v0[3]}), c = gelu_pk((f32x2){v1[0], v1[1]}), d = gelu_pk((f32x2){v1[2], v1[3]});
                        v0 = (f32x4){a.x, a.y, b.x, b.y}; v1 = (f32x4){c.x, c.y, d.x, d.y}; }
                    if (ACT == 2) { v0 = __builtin_elementwise_max(v0, (f32x4){0.f, 0.f, 0.f, 0.f}); v1 = __builtin_elementwise_max(v1, (f32x4){0.f, 0.f, 0.f, 0.f}); v0 = v0 * v0; v1 = v1 * v1; }
                    u32x4 w; w.x = cvt_pk_bf16(v0[0], v0[1]); w.y = cvt_pk_bf16(v0[2], v0[3]); w.z = cvt_pk_bf16(v1[0], v1[1]); w.w = cvt_pk_bf16(v1[2], v1[3]);
                    *(u32x4*)(rowp + bj * HALF) = w; } }
    }
};
struct EpiQ {
    static constexpr bool PERM = true;
    bf16_t* O; const float* cs; float qscale;
    __device__ __forceinline__ void operator()(const f32x4 (&acc)[2][2][4][2], const Unit& u, int wr, int wc, int fr, int fq) const {
        const int row0 = u.pm * BM + wr * 64 + fr;
#pragma unroll
        for (int bj = 0; bj < 2; ++bj) {
            const int c0 = u.pn * BM + bj * HALF + wc * 32 + 8 * fq; const int e = c0 % 192; const bool rope = e >= 128; const int j0 = rope ? ((e - 128) >> 1) : 0;
#pragma unroll
            for (int ai = 0; ai < 2; ++ai)
#pragma unroll
                for (int m = 0; m < 4; ++m) { const int row = row0 + ai * HALF + m * 16;
                    f32x4 v0 = acc[ai][bj][m][0] * qscale, v1 = acc[ai][bj][m][1] * qscale;
                    if (rope) { const f32x4 co = *(const f32x4*)(cs + (size_t)row * 64 + j0), si = *(const f32x4*)(cs + (size_t)row * 64 + 32 + j0);
                        f32x4 r0, r1;
                        r0[0] = v0[0] * co[0] - v0[1] * si[0]; r0[1] = v0[1] * co[0] + v0[0] * si[0];
                        r0[2] = v0[2] * co[1] - v0[3] * si[1]; r0[3] = v0[3] * co[1] + v0[2] * si[1];
                        r1[0] = v1[0] * co[2] - v1[1] * si[2]; r1[1] = v1[1] * co[2] + v1[0] * si[2];
                        r1[2] = v1[2] * co[3] - v1[3] * si[3]; r1[3] = v1[3] * co[3] + v1[2] * si[3];
                        v0 = r0; v1 = r1; }
                    u32x4 w; w.x = cvt_pk_bf16(v0[0], v0[1]); w.y = cvt_pk_bf16(v0[2], v0[3]); w.z = cvt_pk_bf16(v1[0], v1[1]); w.w = cvt_pk_bf16(v1[2], v1[3]);
                    *(u32x4*)(O + (size_t)row * QPITCH + c0) = w; }
        }
    }
};
template <bool XF32> struct EpiRes {
    static constexpr bool PERM = true;
    bf16_t* out; const void* xin; const float* gate; const float* scale;
    __device__ __forceinline__ void operator()(const f32x4 (&acc)[2][2][4][2], const Unit& u, int wr, int wc, int fr, int fq) const {
        const int row0 = u.pm * BM + wr * 64 + fr; const int col0 = u.pn * BM + wc * 32 + 8 * fq;
        const float* gp = gate + (size_t)(u.pm >> 4) * MODW;
#pragma unroll
        for (int bj = 0; bj < 2; ++bj) { const int c = col0 + bj * HALF;
            f32x4 g0 = *(const f32x4*)(gp + c), g1 = *(const f32x4*)(gp + c + 4);
            if (scale) { g0 = g0 * *(const f32x4*)(scale + c); g1 = g1 * *(const f32x4*)(scale + c + 4); }
#pragma unroll
            for (int ai = 0; ai < 2; ++ai)
#pragma unroll
                for (int m = 0; m < 4; ++m) { const size_t off = (size_t)(row0 + ai * HALF + m * 16) * DM + c;
                    const f32x4 x0 = ldx4<XF32>(xin, off / 4), x1 = ldx4<XF32>(xin, off / 4 + 1);
                    const f32x4 v0 = x0 + g0 * acc[ai][bj][m][0], v1 = x1 + g1 * acc[ai][bj][m][1];
                    u32x4 w; w.x = cvt_pk_bf16(v0[0], v0[1]); w.y = cvt_pk_bf16(v0[2], v0[3]); w.z = cvt_pk_bf16(v1[0], v1[1]); w.w = cvt_pk_bf16(v1[2], v1[3]);
                    *(u32x4*)(out + off) = w; } }
    }
};
template <int MODE> struct EpiF32 {
    static constexpr bool PERM = false;
    float* out; int ldc; const float* xin; const float* gate; const float* scale;
    __device__ __forceinline__ void operator()(const f32x4 (&acc)[2][2][4][2], const Unit& u, int wr, int wc, int fr, int fq) const {
        const int row0 = u.pm * BM + wr * 64 + fr; const int col0 = u.pn * BM + wc * 32 + 4 * fq;
        f32x4 gv[2][2];
        if (MODE == 1) { const float* gp = gate + (size_t)(u.pm >> 4) * MODW;
#pragma unroll
            for (int bj = 0; bj < 2; ++bj)
#pragma unroll
                for (int n = 0; n < 2; ++n) { const int c = col0 + bj * HALF + n * 16; f32x4 g = *(const f32x4*)(gp + c); if (scale) g = g * *(const f32x4*)(scale + c); gv[bj][n] = g; } }
#pragma unroll
        for (int ai = 0; ai < 2; ++ai)
#pragma unroll
            for (int m = 0; m < 4; ++m) { const size_t off = (size_t)(row0 + ai * HALF + m * 16) * ldc + col0;
#pragma unroll
                for (int bj = 0; bj < 2; ++bj)
#pragma unroll
                    for (int n = 0; n < 2; ++n) { f32x4 v = acc[ai][bj][m][n];
                        if (MODE == 1) { const f32x4 xi = *(const f32x4*)(xin + off + bj * HALF + n * 16); v = xi + gv[bj][n] * v; }
                        *(f32x4*)(out + off + bj * HALF + n * 16) = v; } }
    }
};

template <class Epi, bool ALIGN_EPI, bool SP2, int K, int LDA, int LDB, int ASTEP>
__device__ __forceinline__ void gemm_phase(LAS unsigned char* lds, const Gemm g, const StaticOrder& S, const Epi& E) {
    const int tid = fresh_tid(), wid = __builtin_amdgcn_readfirstlane(tid >> 6), lane = tid & 63, wr = wid >> 2, wc = wid & 3, fr = lane & 15, fq = lane >> 4;
    constexpr int nt = K / BK;
    unsigned voffA[2], voffB[2];
#pragma unroll
    for (int i = 0; i < 2; ++i) { int R, C; stage_rc(tid * 16 + i * 8192, R, C); const int Rb = Epi::PERM ? ((R & ~31) + perm32(R & 31)) : R;
        voffA[i] = (unsigned)(R * LDA + C) * 2u; voffB[i] = (unsigned)(Rb * LDB + C) * 2u; }
    constexpr size_t kstep = (size_t)(BK * 2);
    constexpr size_t hstepA = (size_t)HALF * LDA * 2, hstepB = (size_t)HALF * LDB * 2;
    constexpr size_t tstepA = 2 * hstepA, tstepB = 2 * hstepB, pnA = (size_t)ASTEP * 2;
    const unsigned ldsw = (unsigned)wid * 1024u;
    const int aoff = lds_byte(wr * 64 + fr, fq * 8), boff = lds_byte(wc * 32 + fr, fq * 8);
#define PG8_SA(b, h) (((b) * 2 + (h)) * HTB)
#define PG8_SB(b, h) ((4 + (b) * 2 + (h)) * HTB)
#define PG8_STAGE(bufoff, gbase, voff) do { _Pragma("unroll") for (int _i = 0; _i < 2; ++_i) \
        __builtin_amdgcn_global_load_lds((const unsigned*)((const char*)(gbase) + (voff)[_i]), (LAS unsigned*)(lds + (bufoff) + ldsw + _i * 8192), 16, 0, 0); } while (0)
#define PG8_LDA(dst, b, h) do { _Pragma("unroll") for (int m = 0; m < 4; ++m) _Pragma("unroll") for (int k = 0; k < 2; ++k) dst[m][k] = *(const LAS bf16x8*)(lds + PG8_SA(b, h) + aoff + m * 2048 + k * 1024); } while (0)
#define PG8_LDB(dst, b, h) do { _Pragma("unroll") for (int n = 0; n < 2; ++n) _Pragma("unroll") for (int k = 0; k < 2; ++k) dst[n][k] = *(const LAS bf16x8*)(lds + PG8_SB(b, h) + boff + n * 2048 + k * 1024); } while (0)
#define PG8_MMA(ai, bj, At, Bt) do { __builtin_amdgcn_s_setprio(1); _Pragma("unroll") for (int m = 0; m < 4; ++m) _Pragma("unroll") for (int n = 0; n < 2; ++n) _Pragma("unroll") for (int k = 0; k < 2; ++k) \
        acc[ai][bj][m][n] = __builtin_amdgcn_mfma_f32_16x16x32_bf16(Bt[n][k], At[m][k], acc[ai][bj][m][n], 0, 0, 0); __builtin_amdgcn_s_setprio(0); } while (0)
#define PG8_WAIT_V(n) asm volatile("s_waitcnt vmcnt(" #n ")" ::: "memory")
#define PG8_WAIT_L(n) asm volatile("s_waitcnt lgkmcnt(" #n ")" ::: "memory")
#define PG8_BAR __builtin_amdgcn_s_barrier()
#define PG8_SCHED __builtin_amdgcn_sched_barrier(0)
    Unit cur, nxt; int ui = 0;
    if (!S.next(0, cur)) return;
    f32x4 acc[2][2][4][2];
#pragma unroll
    for (int a = 0; a < 2; ++a)
#pragma unroll
        for (int b = 0; b < 2; ++b)
#pragma unroll
            for (int m = 0; m < 4; ++m)
#pragma unroll
                for (int n = 0; n < 2; ++n) acc[a][b][m][n] = (f32x4){0.f, 0.f, 0.f, 0.f};
    bf16x8 At[4][2], B0[2][2], B1[2][2];
    const char* cA = (const char*)g.A + (size_t)cur.pm * tstepA + (size_t)cur.pn * pnA; const char* cB = (const char*)g.Bt + (size_t)cur.pn * tstepB;
    if constexpr (SP2) {
        PG8_STAGE(PG8_SB(0, 0), cB, voffB); PG8_STAGE(PG8_SB(0, 1), cB + hstepB, voffB); PG8_STAGE(PG8_SA(0, 0), cA, voffA); PG8_STAGE(PG8_SA(0, 1), cA + hstepA, voffA);
        if (wr == 1) PG8_BAR;
        PG8_WAIT_V(2); PG8_BAR;
        PG8_STAGE(PG8_SB(1, 0), cB + kstep, voffB); PG8_STAGE(PG8_SA(1, 0), cA + kstep, voffA); PG8_STAGE(PG8_SB(1, 1), cB + hstepB + kstep, voffB);
        PG8_WAIT_V(6); PG8_BAR;
    } else {
        PG8_STAGE(PG8_SB(0, 0), cB, voffB); PG8_STAGE(PG8_SA(0, 0), cA, voffA); PG8_STAGE(PG8_SB(0, 1), cB + hstepB, voffB); PG8_STAGE(PG8_SA(0, 1), cA + hstepA, voffA);
        if (wr == 1) PG8_BAR;
        PG8_WAIT_V(4); PG8_BAR;
        PG8_STAGE(PG8_SB(1, 0), cB + kstep, voffB); PG8_STAGE(PG8_SA(1, 0), cA + kstep, voffA); PG8_STAGE(PG8_SB(1, 1), cB + hstepB + kstep, voffB);
        PG8_WAIT_V(6); PG8_BAR;
    }
    for (;;) {
        const bool has_next = S.next(ui + 1, nxt);
        const char* nA = has_next ? (const char*)g.A + (size_t)nxt.pm * tstepA + (size_t)nxt.pn * pnA : cA; const char* nB = has_next ? (const char*)g.Bt + (size_t)nxt.pn * tstepB : cB;
        for (int t = 0; t < nt; t += 2) {
            const bool last = (t == nt - 2);
            const char* a1 = cA + (size_t)(t + 1) * kstep;
            const char* a2 = last ? nA : cA + (size_t)(t + 2) * kstep; const char* b2 = last ? nB : cB + (size_t)(t + 2) * kstep;
            const char* a3 = a2 + kstep; const char* b3 = b2 + kstep;
            if constexpr (SP2) {
            PG8_LDB(B0, 0, 0); PG8_LDB(B1, 0, 1); PG8_SCHED; PG8_LDA(At, 0, 0); PG8_STAGE(PG8_SA(1, 1), a1 + hstepA, voffA);
            PG8_WAIT_V(8); PG8_WAIT_L(0); PG8_BAR; PG8_MMA(0, 0, At, B0); PG8_MMA(0, 1, At, B1); PG8_BAR; PG8_SCHED;
            PG8_LDA(At, 0, 1); PG8_STAGE(PG8_SB(0, 0), b2, voffB); PG8_STAGE(PG8_SB(0, 1), b2 + hstepB, voffB); PG8_STAGE(PG8_SA(0, 0), a2, voffA);
            PG8_WAIT_V(8); PG8_WAIT_L(0); PG8_BAR; PG8_MMA(1, 0, At, B0); PG8_MMA(1, 1, At, B1); PG8_BAR; PG8_SCHED;
            PG8_LDB(B0, 1, 0); PG8_LDB(B1, 1, 1); PG8_SCHED; PG8_LDA(At, 1, 0); PG8_STAGE(PG8_SA(0, 1), a2 + hstepA, voffA);
            PG8_WAIT_V(8); PG8_WAIT_L(0); PG8_BAR; PG8_MMA(0, 0, At, B0); PG8_MMA(0, 1, At, B1); PG8_BAR; PG8_SCHED;
            PG8_LDA(At, 1, 1); PG8_STAGE(PG8_SB(1, 0), b3, voffB); PG8_STAGE(PG8_SB(1, 1), b3 + hstepB, voffB); PG8_STAGE(PG8_SA(1, 0), a3, voffA);
            PG8_WAIT_V(8); PG8_WAIT_L(0); PG8_BAR; PG8_MMA(1, 0, At, B0); PG8_MMA(1, 1, At, B1); PG8_BAR; PG8_SCHED;
            } else {
            PG8_LDB(B0, 0, 0); PG8_SCHED; PG8_LDA(At, 0, 0); PG8_STAGE(PG8_SA(1, 1), a1 + hstepA, voffA);
            PG8_WAIT_L(8); PG8_BAR; PG8_WAIT_L(0); PG8_MMA(0, 0, At, B0); PG8_BAR; PG8_SCHED;
            PG8_LDB(B1, 0, 1); PG8_STAGE(PG8_SB(0, 0), b2, voffB);
            PG8_BAR; PG8_WAIT_L(0); PG8_MMA(0, 1, At, B1); PG8_BAR;
            PG8_LDA(At, 0, 1); PG8_STAGE(PG8_SA(0, 0), a2, voffA);
            PG8_BAR; PG8_WAIT_L(0); PG8_MMA(1, 0, At, B0); PG8_BAR; PG8_SCHED;
            PG8_STAGE(PG8_SB(0, 1), b2 + hstepB, voffB);
            PG8_WAIT_V(6); PG8_BAR; PG8_MMA(1, 1, At, B1); PG8_BAR;
            PG8_LDB(B0, 1, 0); PG8_SCHED; PG8_LDA(At, 1, 0); PG8_STAGE(PG8_SA(0, 1), a2 + hstepA, voffA);
            PG8_WAIT_L(8); PG8_BAR; PG8_WAIT_L(0); PG8_MMA(0, 0, At, B0); PG8_BAR; PG8_SCHED;
            PG8_LDB(B1, 1, 1); PG8_STAGE(PG8_SB(1, 0), b3, voffB);
            PG8_BAR; PG8_WAIT_L(0); PG8_MMA(0, 1, At, B1); PG8_BAR;
            PG8_LDA(At, 1, 1); PG8_STAGE(PG8_SA(1, 0), a3, voffA);
            PG8_BAR; PG8_WAIT_L(0); PG8_MMA(1, 0, At, B0); PG8_BAR; PG8_SCHED;
            PG8_STAGE(PG8_SB(1, 1), b3 + hstepB, voffB);
            PG8_WAIT_V(6); PG8_BAR; PG8_MMA(1, 1, At, B1); PG8_BAR;
            }
        }
        if constexpr (ALIGN_EPI) { if (wr == 0) PG8_BAR; }
        { const int t2 = fresh_tid(), l2 = t2 & 63, w2 = __builtin_amdgcn_readfirstlane(t2 >> 6); E(acc, cur, w2 >> 2, w2 & 3, l2 & 15, l2 >> 4); }
        if (!has_next) break;
#pragma unroll
        for (int a = 0; a < 2; ++a)
#pragma unroll
            for (int b = 0; b < 2; ++b)
#pragma unroll
                for (int m = 0; m < 4; ++m)
#pragma unroll
                    for (int n = 0; n < 2; ++n) acc[a][b][m][n] = (f32x4){0.f, 0.f, 0.f, 0.f};
        cur = nxt; cA = nA; cB = nB; ++ui;
        if constexpr (ALIGN_EPI) { if (wr == 1) PG8_BAR; }
    }
    PG8_WAIT_V(0);
    if constexpr (!ALIGN_EPI) { if (wr == 0) PG8_BAR; }
    PG8_BAR;
#undef PG8_SA
#undef PG8_SB
#undef PG8_STAGE
#undef PG8_LDA
#undef PG8_LDB
#undef PG8_MMA
#undef PG8_WAIT_V
#undef PG8_WAIT_L
#undef PG8_BAR
#undef PG8_SCHED
}
}


#define XB_TMO      128
#define XB_XCNT(j)  (256  + 64 * (j))
#define XB_XSUB(j)  (1280 + 64 * (j))
#define XB_XGEN(j)  (2304 + 64 * (j))
#define XB_TOP      3328
#define XB_TOPGEN   3392
#define XCD_BAR_WORDS 3456
#define XB_SPIN_CAP (1u << 18)
__device__ __forceinline__ unsigned xb_ld(unsigned* p)              { return __hip_atomic_load(p, __ATOMIC_RELAXED, __HIP_MEMORY_SCOPE_AGENT); }
__device__ __forceinline__ unsigned xb_add(unsigned* p, unsigned v) { return __hip_atomic_fetch_add(p, v, __ATOMIC_RELAXED, __HIP_MEMORY_SCOPE_AGENT); }
__device__ __forceinline__ unsigned xb_xcc_id() { return (unsigned)__builtin_amdgcn_s_getreg((3 << 11) | 20) & 0xFu; }
#define XB_SPIN(cond, bar) do { unsigned _sp = 0; while (cond) { __builtin_amdgcn_s_sleep(1); \
    if ((++_sp & 255u) == 0u) { if (xb_ld(&(bar)[XB_TMO])) break; if (_sp > XB_SPIN_CAP) { atomicAdd(&(bar)[XB_TMO], 1u); break; } } } } while (0)
__device__ __forceinline__ void xcd_barrier_complete(unsigned* bar, unsigned x, unsigned& nloc, unsigned& nx) {
    const unsigned G = gridDim.x * gridDim.y * gridDim.z;
    unsigned sum, cnt, mine, sp = 0u;
    for (;;) {
        sum = 0u; cnt = 0u; mine = 0u;
#pragma unroll
        for (unsigned j = 0; j < 16; ++j) { const unsigned c = xb_ld(&bar[XB_XCNT(j)]); sum += c; cnt += (c > 0u) ? 1u : 0u; mine = (j == x) ? c : mine; }
        if (sum == G) break;
        __builtin_amdgcn_s_sleep(1);
        if ((++sp & 255u) == 0u) { if (xb_ld(&bar[XB_TMO])) break; if (sp > XB_SPIN_CAP) { atomicAdd(&bar[XB_TMO], 1u); break; } }
    }
    nloc = mine > 0u ? mine : 1u; nx = cnt > 0u ? cnt : 1u;
}
__device__ __forceinline__ void xcd_barrier(unsigned* bar, volatile LAS unsigned* st, bool allow_local) {
    asm volatile("s_waitcnt vmcnt(0)" ::: "memory");
    __syncthreads();
    if (threadIdx.x == 0) {
        const unsigned x = xb_xcc_id();
        __builtin_amdgcn_s_waitcnt(0);
        unsigned nloc = st[0], nx = st[1];
        if (nloc == 0u) { xcd_barrier_complete(bar, x, nloc, nx); st[0] = nloc; st[1] = nx; }
        const bool local = allow_local && st[2] != 0u;
        const unsigned old = xb_add(&bar[XB_XSUB(x)], 1u);
        const unsigned gen = old / nloc;
        if (old + 1u == (gen + 1u) * nloc) {
            __builtin_amdgcn_fence(__ATOMIC_RELEASE, "agent");
            asm volatile("s_waitcnt vmcnt(0)" ::: "memory");
            if (!local) {
                const unsigned og = xb_add(&bar[XB_TOP], 1u);
                const unsigned tg = og / nx;
                if (og + 1u == (tg + 1u) * nx) xb_add(&bar[XB_TOPGEN], 1u);
                else XB_SPIN(xb_ld(&bar[XB_TOPGEN]) == tg, bar);
            }
            __builtin_amdgcn_fence(__ATOMIC_ACQUIRE, "agent");
            xb_add(&bar[XB_XGEN(x)], 1u);
            asm volatile("s_waitcnt vmcnt(0)" ::: "memory");
        } else {
            XB_SPIN(xb_ld(&bar[XB_XGEN(x)]) == gen, bar);
            __builtin_amdgcn_fence(__ATOMIC_ACQUIRE, "agent");
            asm volatile("s_waitcnt vmcnt(0)" ::: "memory");
        }
    }
    __syncthreads();
}
struct WMap { int local, grp, rank; };
__device__ __forceinline__ WMap ldmap(LAS unsigned char* lds) {
    volatile LAS unsigned* st = (volatile LAS unsigned*)(lds + 131072 + 64); WMap m;
    m.local = __builtin_amdgcn_readfirstlane((int)st[2]); m.grp = __builtin_amdgcn_readfirstlane((int)st[3]); m.rank = __builtin_amdgcn_readfirstlane((int)st[4]); return m;
}

struct Params {
    const float* x; const float* c; const int* pos; const float* ada_w; const float* ada_b; const float* norm_mix_g; const float* norm_mlp_g;
    const float* pool_w; const float* pool_scale; const float* sgu_w_in; const float* sgu_ln_g; const float* sgu_ln_b; const float* sgu_w_s; const float* sgu_b_s; const float* sgu_w_out;
    const float* mla_w_dq_dkv; const float* mla_q_norm_g; const float* mla_kv_norm_g; const float* mla_w_uq; const float* mla_w_ukv; const float* mla_w_o;
    const float* mlp_w1; const float* mlp_w2; const float* final_g;
    float* out; unsigned char* ws;
};

__device__ __forceinline__ const void* ldarg(int byte_off) {
    const void* r; auto kp = __builtin_amdgcn_kernarg_segment_ptr();
    asm volatile("s_load_dwordx2 %0, %1, %2\n\ts_waitcnt lgkmcnt(0)" : "=s"(r) : "s"(kp), "i"(byte_off) : "memory");
    return r;
}
#define PA(field) ((decltype(Params::field))ldarg((int)offsetof(Params, field)))
__device__ __forceinline__ void p0_transpose_item(const float* W, int K, int N, bf16_t* WT, int row_off, LAS float* scr, int item, int lane) {
    const int nblk = N / 32, kb = item / nblk, nb = item % nblk, k0 = 64 * kb, n0 = 32 * nb;
    float tv[32];
#pragma unroll
    for (int i = 0; i < 32; ++i) { const int kk = 2 * i + (lane >> 5); tv[i] = W[(size_t)(k0 + kk) * N + n0 + (lane & 31)]; }
#pragma unroll
    for (int i = 0; i < 32; ++i) { const int kk = 2 * i + (lane >> 5); scr[kk * 33 + (lane & 31)] = tv[i]; }
    asm volatile("s_waitcnt lgkmcnt(0)" ::: "memory");
    const int c = lane & 7;
#pragma unroll
    for (int j = 0; j < 4; ++j) { const int n = (lane >> 3) + 8 * j; const LAS float* s = scr + (8 * c) * 33 + n;
        u32x4 o; o.x = cvt_pk_bf16(s[0 * 33], s[1 * 33]); o.y = cvt_pk_bf16(s[2 * 33], s[3 * 33]); o.z = cvt_pk_bf16(s[4 * 33], s[5 * 33]); o.w = cvt_pk_bf16(s[6 * 33], s[7 * 33]);
        *(u32x4*)(WT + (size_t)(row_off + n0 + n) * K + k0 + 8 * c) = o; }
    asm volatile("s_waitcnt lgkmcnt(0)" ::: "memory");
}

__device__ __forceinline__ void rope_cs(int pos, int j, float& co, float& si) {
    double inv = 1.0; const double base = 0.74989420933245582730;
    for (int i = 0; i < j; ++i) inv *= base;
    const double ang = (double)pos * inv;
    const double q = rint(ang * 0.63661977236758134308);
    double r = fma(-q, 1.5707963267948966192, ang); r = fma(-q, 6.123233995736766e-17, r);
    const int qi = (int)((long long)q & 3);
    const double r2 = r * r;
    const double sn = r * (1.0 + r2 * (-1.0 / 6 + r2 * (1.0 / 120 + r2 * (-1.0 / 5040 + r2 * (1.0 / 362880 + r2 * (-1.0 / 39916800))))));
    const double cn = 1.0 + r2 * (-0.5 + r2 * (1.0 / 24 + r2 * (-1.0 / 720 + r2 * (1.0 / 40320 + r2 * (-1.0 / 3628800 + r2 * (1.0 / 479001600))))));
    double c, s;
    if (qi == 0) { c = cn; s = sn; } else if (qi == 1) { c = -sn; s = cn; } else if (qi == 2) { c = -cn; s = -sn; } else { c = sn; s = -cn; }
    co = (float)c; si = (float)s;
}

__device__ __forceinline__ void prologue(LAS unsigned char* lds, int G) {
    const int tid = fresh_tid(), lane = tid & 63, wave = __builtin_amdgcn_readfirstlane(tid >> 6), bx = fresh_s(blockIdx.x); G = fresh_s(G);
    unsigned char* ws = PA(ws);
    {
        LAS float* cact = (LAS float*)lds;
        LAS float* red = (LAS float*)(lds + 32768);
        for (int i = tid; i < BATCH * DM; i += NTHREADS) { const float v = PA(c)[i]; cact[i] = v / (1.0f + __expf(-v)); }
        __syncthreads();
        float* mod = (float*)(ws + OFF_MOD);
        for (int item = bx; item < DEPTH * (MODW / 32); item += G) {
            const int li = item / (MODW / 32), n0 = (item % (MODW / 32)) * 32, col = tid & 31, kp = tid >> 5;
            const float* W = PA(ada_w) + (size_t)li * DM * MODW + n0 + col;
            float a[8];
#pragma unroll
            for (int b = 0; b < 8; ++b) a[b] = 0.f;
#pragma unroll 16
            for (int kk = 0; kk < 64; ++kk) { const int k = kp * 64 + kk; const float w = W[(size_t)k * MODW];
#pragma unroll
                for (int b = 0; b < 8; ++b) a[b] += cact[b * DM + k] * w; }
#pragma unroll
            for (int b = 0; b < 8; ++b) red[(kp * 8 + b) * 32 + col] = a[b];
            __syncthreads();
            if (tid < 256) { const int b = tid >> 5; float s = PA(ada_b)[(size_t)li * MODW + n0 + col];
#pragma unroll
                for (int k2 = 0; k2 < 16; ++k2) s += red[(k2 * 8 + b) * 32 + col];
                mod[((size_t)li * 8 + b) * MODW + n0 + col] = s; }
            __syncthreads();
        }
    }
    {
        LAS float* T = (LAS float*)lds;
        bf16_t* QA = (bf16_t*)(ws + OFF_QABS); bf16_t* OA = (bf16_t*)(ws + OFF_OABS);
        for (int item = bx; item < 256; item += G) {
            const int which = item >> 7, h = (item >> 3) & 15, lb = item & 7;
            __syncthreads();
            { const int idx = tid * 4, ll = idx >> 7, d = idx & 127;
              const f32x4 v = *(const f32x4*)(PA(mla_w_ukv) + (size_t)(lb * 16 + ll) * 4096 + h * 256 + which * 128 + d);
              *(LAS f32x4*)(T + ll * 128 + d) = v; }
            __syncthreads();
            if (which == 0) {
                const int i = tid & 255, half = tid >> 8;
                float a[8];
#pragma unroll
                for (int l = 0; l < 8; ++l) a[l] = 0.f;
                const float* qrow = PA(mla_w_uq) + (size_t)i * 3072 + h * 192;
                for (int d4 = 0; d4 < 32; ++d4) { const f32x4 q4 = *(const f32x4*)(qrow + d4 * 4);
#pragma unroll
                    for (int l = 0; l < 8; ++l) { const f32x4 t4 = *(const LAS f32x4*)(T + (half * 8 + l) * 128 + d4 * 4); a[l] += q4[0] * t4[0] + q4[1] * t4[1] + q4[2] * t4[2] + q4[3] * t4[3]; } }
#pragma unroll
                for (int l = 0; l < 8; ++l) { const unsigned pk = cvt_pk_bf16(a[l], 0.f); QA[(size_t)(h * 192 + lb * 16 + half * 8 + l) * 256 + i] = (bf16_t)(pk & 0xffffu); }
            } else {
                float a0[16], a1[16];
#pragma unroll
                for (int l = 0; l < 16; ++l) { a0[l] = 0.f; a1[l] = 0.f; }
                const float* wo = PA(mla_w_o) + (size_t)(h * 128) * 1024 + 2 * tid;
                for (int dv4 = 0; dv4 < 32; ++dv4) {
                    f32x2 w[4];
#pragma unroll
                    for (int e = 0; e < 4; ++e) w[e] = *(const f32x2*)(wo + (size_t)(dv4 * 4 + e) * 1024);
#pragma unroll
                    for (int l = 0; l < 16; ++l) { const f32x4 t4 = *(const LAS f32x4*)(T + l * 128 + dv4 * 4);
#pragma unroll
                        for (int e = 0; e < 4; ++e) { a0[l] += t4[e] * w[e].x; a1[l] += t4[e] * w[e].y; } } }
#pragma unroll
                for (int nn = 0; nn < 2; ++nn) { bf16_t* dst = OA + (size_t)(2 * tid + nn) * 2048 + h * 128 + lb * 16;
                    u32x4 o0, o1;
                    if (nn == 0) { o0.x = cvt_pk_bf16(a0[0], a0[1]); o0.y = cvt_pk_bf16(a0[2], a0[3]); o0.z = cvt_pk_bf16(a0[4], a0[5]); o0.w = cvt_pk_bf16(a0[6], a0[7]);
                                   o1.x = cvt_pk_bf16(a0[8], a0[9]); o1.y = cvt_pk_bf16(a0[10], a0[11]); o1.z = cvt_pk_bf16(a0[12], a0[13]); o1.w = cvt_pk_bf16(a0[14], a0[15]); }
                    else         { o0.x = cvt_pk_bf16(a1[0], a1[1]); o0.y = cvt_pk_bf16(a1[2], a1[3]); o0.z = cvt_pk_bf16(a1[4], a1[5]); o0.w = cvt_pk_bf16(a1[6], a1[7]);
                                   o1.x = cvt_pk_bf16(a1[8], a1[9]); o1.y = cvt_pk_bf16(a1[10], a1[11]); o1.z = cvt_pk_bf16(a1[12], a1[13]); o1.w = cvt_pk_bf16(a1[14], a1[15]); }
                    *(u32x4*)dst = o0; *(u32x4*)(dst + 8) = o1; }
            }
        }
        __syncthreads();
    }
    {
        const int gt = bx * NTHREADS + tid, NGT = G * NTHREADS;
        bf16_t* QA = (bf16_t*)(ws + OFF_QABS);
        for (int idx = gt; idx < 16 * 64 * 256; idx += NGT) {
            const int i = idx & 255, e = (idx >> 8) & 63, h = idx >> 14, j = e >> 1, pp = e & 1;
            const float v = PA(mla_w_uq)[(size_t)i * 3072 + h * 192 + 128 + j + 32 * pp];
            QA[(size_t)(h * 192 + 128 + e) * 256 + i] = (bf16_t)(cvt_pk_bf16(v, 0.f) & 0xffffu);
        }
        bf16_t* WSB = (bf16_t*)(ws + OFF_WSB);
        for (int idx = gt; idx < 8 * 128 * 128; idx += NGT) { const int s = idx & 127, t = (idx >> 7) & 127; const float v = (s <= t) ? PA(sgu_w_s)[idx] : 0.f; WSB[idx] = (bf16_t)(cvt_pk_bf16(v, 0.f) & 0xffffu); }
        unsigned* LZ = (unsigned*)(ws + OFF_LATT + (size_t)448 * 1024 * 2);
        for (int idx = gt; idx < 64 * 1024 / 2; idx += NGT) LZ[idx] = 0u;
        float* cs = (float*)(ws + OFF_CS);
        for (int idx = gt; idx < M * 32; idx += NGT) { const int m = idx >> 5, j = idx & 31; float co, si; rope_cs(PA(pos)[m], j, co, si); cs[(size_t)m * 64 + j] = co; cs[(size_t)m * 64 + 32 + j] = si; }
    }
    {
        LAS float* scr = (LAS float*)(lds + wave * 16384);
        const int gw = bx * NWAVES + wave, NGW = G * NWAVES;
        constexpr int I_POOL = 8 * 4 * 8, I_IN = 16 * 64, I_OUT = 16 * 32, I_LAT = 16 * 14, I_W1 = 16 * 128, I_W2 = 64 * 32;
        constexpr int NITEMS = I_POOL + I_IN + I_OUT + I_LAT + 4 * I_W1 + 4 * I_W2;
        for (int it = gw; it < NITEMS; it += NGW) {
            int r = it;
            if (r < I_POOL) { const int mat = r >> 5, l = mat >> 2, gq = mat & 3; p0_transpose_item(PA(pool_w) + (size_t)mat * 65536, 256, 256, (bf16_t*)(ws + OFF_POOLT) + (size_t)l * 1024 * 256, gq * 256, scr, r & 31, lane); continue; } r -= I_POOL;
            if (r < I_IN) { p0_transpose_item(PA(sgu_w_in), 1024, 2048, (bf16_t*)(ws + OFF_SGUIN), 0, scr, r, lane); continue; } r -= I_IN;
            if (r < I_OUT) { p0_transpose_item(PA(sgu_w_out), 1024, 1024, (bf16_t*)(ws + OFF_SGUOUT), 0, scr, r, lane); continue; } r -= I_OUT;
            if (r < I_LAT) { p0_transpose_item(PA(mla_w_dq_dkv), 1024, 448, (bf16_t*)(ws + OFF_LATT), 0, scr, r, lane); continue; } r -= I_LAT;
            if (r < 4 * I_W1) { const int li = r / I_W1; p0_transpose_item(PA(mlp_w1) + (size_t)li * DM * FF, DM, FF, (bf16_t*)(ws + OFF_W1T) + (size_t)li * DM * FF, 0, scr, r % I_W1, lane); continue; } r -= 4 * I_W1;
            { const int li = r / I_W2; p0_transpose_item(PA(mlp_w2) + (size_t)li * DM * FF, FF, DM, (bf16_t*)(ws + OFF_W2T) + (size_t)li * DM * FF, 0, scr, r % I_W2, lane); }
        }
    }
}

template <bool XF32> __device__ __forceinline__ void norm_mod_phase(const void* __restrict__ xin, bf16_t* __restrict__ H, const float* g, const float* shift, const float* scale, int G, WMap mp) {
    const int tid = fresh_tid(), lane = tid & 63, wave = __builtin_amdgcn_readfirstlane(tid >> 6); const int gw = fresh_s(blockIdx.x) * NWAVES + wave, NGW = fresh_s(G) * NWAVES;
    const int it0 = mp.local ? mp.grp * 1024 + mp.rank * 8 + wave : gw, itstep = mp.local ? 256 : NGW, itend = mp.local ? (mp.grp + 1) * 1024 : M / 4;
    for (int it = it0; it < itend; it += itstep) {
        const int m0 = it * 4, b = m0 >> 12;
        f32x4 v[4][4]; float s[4];
#pragma unroll
        for (int r = 0; r < 4; ++r) {
#pragma unroll
            for (int j = 0; j < 4; ++j) v[r][j] = ldx4<XF32>(xin, (size_t)(m0 + r) * (DM / 4) + lane + 64 * j); }
#pragma unroll
        for (int r = 0; r < 4; ++r) { float t = 0.f;
#pragma unroll
            for (int j = 0; j < 4; ++j) t += (v[r][j][0] * v[r][j][0] + v[r][j][1] * v[r][j][1]) + (v[r][j][2] * v[r][j][2] + v[r][j][3] * v[r][j][3]);
            s[r] = t; }
#pragma unroll
        for (int o = 1; o < 64; o <<= 1) {
#pragma unroll
            for (int r = 0; r < 4; ++r) s[r] += shfl_x(s[r], lane, o); }
        float rstd[4];
#pragma unroll
        for (int r = 0; r < 4; ++r) rstd[r] = rsqrtf(s[r] * (1.f / DM) + RMS_EPS);
#pragma unroll
        for (int j = 0; j < 4; ++j) { const int col = 4 * lane + 256 * j;
            const f32x4 gg = *(const f32x4*)(g + col), sc = *(const f32x4*)(scale + (size_t)b * MODW + col), sh = *(const f32x4*)(shift + (size_t)b * MODW + col);
            const f32x4 gm = gg * (sc + 1.0f);
#pragma unroll
            for (int r = 0; r < 4; ++r) { const f32x4 y = v[r][j] * rstd[r] * gm + sh;
                u32x2 w; w.x = cvt_pk_bf16(y[0], y[1]); w.y = cvt_pk_bf16(y[2], y[3]); *((u32x2*)(H + (size_t)(m0 + r) * DM) + lane + 64 * j) = w; } }
    }
}
__device__ __forceinline__ void final_norm_phase(const bf16_t* __restrict__ xb, float* __restrict__ xo, const float* g, int G, WMap mp) {
    const int tid = fresh_tid(), lane = tid & 63, wave = __builtin_amdgcn_readfirstlane(tid >> 6); const int gw = fresh_s(blockIdx.x) * NWAVES + wave, NGW = fresh_s(G) * NWAVES;
    const int it0 = mp.local ? mp.grp * 1024 + mp.rank * 8 + wave : gw, itstep = mp.local ? 256 : NGW, itend = mp.local ? (mp.grp + 1) * 1024 : M / 4;
    for (int it = it0; it < itend; it += itstep) {
        const int m0 = it * 4;
        f32x4 v[4][4]; float s[4];
#pragma unroll
        for (int r = 0; r < 4; ++r) {
#pragma unroll
            for (int j = 0; j < 4; ++j) v[r][j] = ldx4<false>(xb, (size_t)(m0 + r) * (DM / 4) + lane + 64 * j); }
#pragma unroll
        for (int r = 0; r < 4; ++r) { float t = 0.f;
#pragma unroll
            for (int j = 0; j < 4; ++j) t += (v[r][j][0] * v[r][j][0] + v[r][j][1] * v[r][j][1]) + (v[r][j][2] * v[r][j][2] + v[r][j][3] * v[r][j][3]);
            s[r] = t; }
#pragma unroll
        for (int o = 1; o < 64; o <<= 1) {
#pragma unroll
            for (int r = 0; r < 4; ++r) s[r] += shfl_x(s[r], lane, o); }
#pragma unroll
        for (int j = 0; j < 4; ++j) { const f32x4 gg = *(const f32x4*)(g + 4 * lane + 256 * j);
#pragma unroll
            for (int r = 0; r < 4; ++r) { const float rstd = rsqrtf(s[r] * (1.f / DM) + RMS_EPS); *((f32x4*)(xo + (size_t)(m0 + r) * DM) + lane + 64 * j) = v[r][j] * rstd * gg; } }
    }
}

template <int W, bool XF32> __device__ __forceinline__ void pool_cols(const void* __restrict__ xin, bf16_t* __restrict__ out, bf16_t* __restrict__ xcopy, long row0, bool has_halo, const LAS float* rs, f32x2 Gm, f32x2 SH, int tid) {
    float r0[16], r1[16];
#pragma unroll
    for (int k = 0; k < 16; ++k) { r0[k] = 0.f; r1[k] = 0.f; }
    const int rlo = has_halo ? 0 : 15; const size_t xi2 = (size_t)(row0 - 15) * (DM / 2) + tid;
    for (int c = 0; c < 5; ++c) {
        f32x2 xv[16];
#pragma unroll
        for (int k = 0; k < 16; ++k) { int r = c * 16 + k; r = r < rlo ? rlo : (r > 78 ? 78 : r);
            xv[k] = ldx2<XF32>(xin, xi2 + (size_t)r * (DM / 2)); }
#pragma unroll
        for (int k = 0; k < 16; ++k) {
            const int r = c * 16 + k;
            if (r < 79) {
                float h0 = 0.f, h1 = 0.f;
                if (has_halo || r >= 15) { const float rr = rs[r]; h0 = xv[k].x * rr * Gm.x + SH.x; h1 = xv[k].y * rr * Gm.y + SH.y; }
                r0[k] = h0; r1[k] = h1;
                if (r >= 15) {
                    if (XF32) *(unsigned*)(xcopy + (size_t)(row0 + r - 15) * DM + 2 * tid) = cvt_pk_bf16(xv[k].x, xv[k].y);
                    float s0 = 0.f, s1 = 0.f;
#pragma unroll
                    for (int i = 0; i < W; ++i) { s0 += r0[(k - i) & 15]; s1 += r1[(k - i) & 15]; }
                    const int tb = (int)((row0 + r - 15) & (SEQ - 1)); const int cnt = (tb + 1) < W ? (tb + 1) : W; const float ic = 1.0f / (float)cnt;
                    *(unsigned*)(out + (size_t)(row0 + r - 15) * DM + 2 * tid) = cvt_pk_bf16(s0 * ic - h0, s1 * ic - h1);
                }
            }
        }
    }
}
template <bool XF32> __device__ __forceinline__ void pool_pre_phase(LAS unsigned char* lds, const void* __restrict__ xin, bf16_t* __restrict__ H, bf16_t* __restrict__ xcopy, const float* g, const float* shift, const float* scale, int G, WMap mp) {
    const int tid = fresh_tid(), lane = tid & 63, wave = __builtin_amdgcn_readfirstlane(tid >> 6);
    LAS float* rs = (LAS float*)lds;
    G = fresh_s(G);
    const int it0 = mp.local ? mp.grp * 64 + mp.rank : fresh_s(blockIdx.x), itstep = mp.local ? 32 : G, itend = mp.local ? (mp.grp + 1) * 64 : M / 64;
    for (int item = it0; item < itend; item += itstep) {
        const long row0 = (long)item * 64; const bool has_halo = (row0 & (SEQ - 1)) != 0; const int b = (int)(row0 >> 12);
        __syncthreads();
        const int rlo = has_halo ? 0 : 15;
        for (int half = 0; half < 2; ++half) {
            f32x4 v[5][4];
#pragma unroll
            for (int i = 0; i < 5; ++i) { int r = wave * 10 + half * 5 + i; r = r < rlo ? rlo : (r > 78 ? 78 : r);
#pragma unroll
                for (int j = 0; j < 4; ++j) v[i][j] = ldx4<XF32>(xin, (size_t)(row0 - 15 + r) * (DM / 4) + lane + 64 * j); }
#pragma unroll
            for (int i = 0; i < 5; ++i) { const int r = wave * 10 + half * 5 + i; float s = 0.f;
#pragma unroll
                for (int j = 0; j < 4; ++j) s += (v[i][j][0] * v[i][j][0] + v[i][j][1] * v[i][j][1]) + (v[i][j][2] * v[i][j][2] + v[i][j][3] * v[i][j][3]);
                const float rstd = rsqrtf(wave_sum(s, lane) * (1.f / DM) + RMS_EPS);
                if (lane == 0 && r < 79) rs[r] = rstd; }
        }
        __syncthreads();
        const int col = 2 * tid;
        const f32x2 gg = *(const f32x2*)(g + col), sc = *(const f32x2*)(scale + (size_t)b * MODW + col), sh = *(const f32x2*)(shift + (size_t)b * MODW + col);
        const f32x2 Gm = gg * (sc + 1.0f);
        const int grp = wave >> 1;
        if (grp == 0) pool_cols<2, XF32>(xin, H, xcopy, row0, has_halo, rs, Gm, sh, tid);
        else if (grp == 1) pool_cols<4, XF32>(xin, H, xcopy, row0, has_halo, rs, Gm, sh, tid);
        else if (grp == 2) pool_cols<8, XF32>(xin, H, xcopy, row0, has_halo, rs, Gm, sh, tid);
        else pool_cols<16, XF32>(xin, H, xcopy, row0, has_halo, rs, Gm, sh, tid);
    }
    __syncthreads();
}

__device__ __forceinline__ void sgu_spatial_phase(LAS unsigned char* lds, const bf16_t* Z, const bf16_t* WSB, const float* ln_g, const float* ln_b, const float* b_s, bf16_t* GT, int G, WMap mp) {
    const int tid = fresh_tid(), lane = tid & 63, wave = __builtin_amdgcn_readfirstlane(tid >> 6);
    LAS float* st = (LAS float*)lds;
    LAS bf16_t* VT = (LAS bf16_t*)(lds + 1024);
    constexpr int VP = 136;
    G = fresh_s(G);
    const int it0 = mp.local ? mp.grp * 32 + mp.rank : fresh_s(blockIdx.x), itstep = mp.local ? 32 : G, itend = mp.local ? (mp.grp + 1) * 32 : M / 128;
    for (int item = it0; item < itend; item += itstep) {
        const size_t tok0 = (size_t)item * 128;
        __syncthreads();
        for (int rr = 0; rr < 16; ++rr) { const int row = wave * 16 + rr; const bf16_t* vp = Z + (tok0 + row) * 2048 + 1024 + 8 * lane;
            const u32x4 a = *(const u32x4*)vp, bq = *(const u32x4*)(vp + 512);
            float f[16]; f[0] = bflo(a.x); f[1] = bfhi(a.x); f[2] = bflo(a.y); f[3] = bfhi(a.y); f[4] = bflo(a.z); f[5] = bfhi(a.z); f[6] = bflo(a.w); f[7] = bfhi(a.w);
            f[8] = bflo(bq.x); f[9] = bfhi(bq.x); f[10] = bflo(bq.y); f[11] = bfhi(bq.y); f[12] = bflo(bq.z); f[13] = bfhi(bq.z); f[14] = bflo(bq.w); f[15] = bfhi(bq.w);
            float s = 0.f;
#pragma unroll
            for (int i = 0; i < 16; ++i) s += f[i];
            const float mean = wave_sum(s, lane) * (1.f / 1024); float q = 0.f;
#pragma unroll
            for (int i = 0; i < 16; ++i) { const float d = f[i] - mean; q += d * d; }
            const float rstd = rsqrtf(wave_sum(q, lane) * (1.f / 1024) + LN_EPS);
            if (lane == 0) { st[row * 2] = mean; st[row * 2 + 1] = rstd; } }
        __syncthreads();
        for (int hd = 0; hd < 8; ++hd) {
#pragma unroll
            for (int it = 0; it < 4; ++it) { const int idx = it * NTHREADS + tid, s = idx & 127, c8 = idx >> 7;
                const u32x4 a = *(const u32x4*)(Z + (tok0 + s) * 2048 + 1024 + hd * 128 + c8 * 8);
                const float mean = st[s * 2], rstd = st[s * 2 + 1];
                const f32x4 g0 = *(const f32x4*)(ln_g + hd * 128 + c8 * 8), g1 = *(const f32x4*)(ln_g + hd * 128 + c8 * 8 + 4);
                const f32x4 b0 = *(const f32x4*)(ln_b + hd * 128 + c8 * 8), b1 = *(const f32x4*)(ln_b + hd * 128 + c8 * 8 + 4);
                float y[8];
                y[0] = (bflo(a.x) - mean) * rstd * g0[0] + b0[0]; y[1] = (bfhi(a.x) - mean) * rstd * g0[1] + b0[1];
                y[2] = (bflo(a.y) - mean) * rstd * g0[2] + b0[2]; y[3] = (bfhi(a.y) - mean) * rstd * g0[3] + b0[3];
                y[4] = (bflo(a.z) - mean) * rstd * g1[0] + b1[0]; y[5] = (bfhi(a.z) - mean) * rstd * g1[1] + b1[1];
                y[6] = (bflo(a.w) - mean) * rstd * g1[2] + b1[2]; y[7] = (bfhi(a.w) - mean) * rstd * g1[3] + b1[3];
#pragma unroll
                for (int i = 0; i < 8; i += 2) { const unsigned pk = cvt_pk_bf16(y[i], y[i + 1]); VT[(c8 * 8 + i) * VP + s] = (bf16_t)(pk & 0xffffu); VT[(c8 * 8 + i + 1) * VP + s] = (bf16_t)(pk >> 16); } }
            __syncthreads();
            const int tb = wave & 3, ch = wave >> 2, r32 = lane & 31, hi = lane >> 5;
            f32x16 acc0, acc1;
#pragma unroll
            for (int r = 0; r < 16; ++r) { acc0[r] = 0.f; acc1[r] = 0.f; }
            const bf16_t* wp = WSB + (size_t)hd * 16384 + (tb * 32 + r32) * 128 + 8 * hi;
            const LAS bf16_t* vb = VT + (ch * 64 + r32) * VP + 8 * hi;
            for (int ks = 0; ks < 2 * (tb + 1); ++ks) {
                const bf16x8 a = *(const bf16x8*)(wp + ks * 16);
                const bf16x8 b0 = *(const LAS bf16x8*)(vb + ks * 16), b1 = *(const LAS bf16x8*)(vb + 32 * VP + ks * 16);
                acc0 = __builtin_amdgcn_mfma_f32_32x32x16_bf16(a, b0, acc0, 0, 0, 0);
                acc1 = __builtin_amdgcn_mfma_f32_32x32x16_bf16(a, b1, acc1, 0, 0, 0);
            }
#pragma unroll
            for (int r = 0; r < 16; ++r) { const int t = tb * 32 + (r & 3) + 8 * (r >> 2) + 4 * hi; const float bias = b_s[hd * 128 + t];
                const int c = hd * 128 + ch * 64 + r32;
                const float u0 = bf2f(Z[(tok0 + t) * 2048 + c]), u1 = bf2f(Z[(tok0 + t) * 2048 + c + 32]);
                GT[(tok0 + t) * 1024 + c] = (bf16_t)(cvt_pk_bf16(u0 * (acc0[r] + bias), 0.f) & 0xffffu);
                GT[(tok0 + t) * 1024 + c + 32] = (bf16_t)(cvt_pk_bf16(u1 * (acc1[r] + bias), 0.f) & 0xffffu); }
            __syncthreads();
        }
    }
}

__device__ __forceinline__ void lat_norm_phase(const float* LAT, const float* cs, const float* qg, const float* kvg, bf16_t* CQ, bf16_t* KK, bf16_t* VT, int G, WMap mp) {
    const int tid = fresh_tid(), lane = tid & 63, wave = __builtin_amdgcn_readfirstlane(tid >> 6); const int gw = fresh_s(blockIdx.x) * NWAVES + wave, NGW = fresh_s(G) * NWAVES;
    const f32x4 qg4 = *(const f32x4*)(qg + 4 * lane); const f32x2 kg2 = *(const f32x2*)(kvg + 2 * lane);
    const int it0 = mp.local ? mp.grp * 512 + mp.rank * 8 + wave : gw, itstep = mp.local ? 256 : NGW, itend = mp.local ? (mp.grp + 1) * 512 : M / 8;
    for (int item = it0; item < itend; item += itstep) {
        const int t0 = item * 8, b = t0 >> 12;
        float k0[8], k1[8];
#pragma unroll
        for (int tt = 0; tt < 8; ++tt) { const size_t row = (size_t)t0 + tt; const float* lp = LAT + row * LATPITCH;
            const f32x4 q4 = *(const f32x4*)(lp + 4 * lane); const f32x2 kv2 = *(const f32x2*)(lp + 256 + 2 * lane); const float kr = lp[384 + lane];
            const float rq = rsqrtf(wave_sum((q4[0] * q4[0] + q4[1] * q4[1]) + (q4[2] * q4[2] + q4[3] * q4[3]), lane) * (1.f / 256) + RMS_EPS);
            const float rkv = rsqrtf(wave_sum(kv2.x * kv2.x + kv2.y * kv2.y, lane) * (1.f / 128) + RMS_EPS);
            const f32x4 cq = q4 * rq * qg4; u32x2 w; w.x = cvt_pk_bf16(cq[0], cq[1]); w.y = cvt_pk_bf16(cq[2], cq[3]); *(u32x2*)(CQ + row * 256 + 4 * lane) = w;
            const float n0 = kv2.x * rkv * kg2.x, n1 = kv2.y * rkv * kg2.y; const unsigned pk = cvt_pk_bf16(n0, n1); *(unsigned*)(KK + row * 192 + 2 * lane) = pk;
            k0[tt] = bflo(pk); k1[tt] = bfhi(pk);
            const float partner = shfl_x(kr, lane, 32); const int j = lane & 31; const float co = cs[row * 64 + j], si = cs[row * 64 + 32 + j];
            const float val = (lane < 32) ? (kr * co - partner * si) : (kr * co + partner * si);
            KK[row * 192 + 128 + 2 * j + (lane >> 5)] = (bf16_t)(cvt_pk_bf16(val, 0.f) & 0xffffu); }
        u32x4 o0, o1;
        o0.x = cvt_pk_bf16(k0[0], k0[1]); o0.y = cvt_pk_bf16(k0[2], k0[3]); o0.z = cvt_pk_bf16(k0[4], k0[5]); o0.w = cvt_pk_bf16(k0[6], k0[7]);
        o1.x = cvt_pk_bf16(k1[0], k1[1]); o1.y = cvt_pk_bf16(k1[2], k1[3]); o1.z = cvt_pk_bf16(k1[4], k1[5]); o1.w = cvt_pk_bf16(k1[6], k1[7]);
        *(u32x4*)(VT + ((size_t)b * 128 + 2 * lane) * SEQ + (t0 & (SEQ - 1))) = o0;
        *(u32x4*)(VT + ((size_t)b * 128 + 2 * lane + 1) * SEQ + (t0 & (SEQ - 1))) = o1;
    }
}

__device__ __forceinline__ void attn_phase(LAS unsigned char* lds, const bf16_t* Q, const bf16_t* KK, const bf16_t* VT, bf16_t* OL, int vcu, int G) {
    const int tid = fresh_tid(), lane = tid & 63, wave = __builtin_amdgcn_readfirstlane(tid >> 6), q = lane & 31, hi = lane >> 5;
    constexpr int KPB = 400, VPB = 136  , KBYTES = 64 * KPB, VBYTES = 128 * VPB, BUF = KBYTES + VBYTES;
    constexpr float ATT_THR = 8.0f;
    G = fresh_s(G); vcu = fresh_s(vcu);
    for (int U = vcu; U < 2048; U += G) {
        const int v = U & 255, iu = U >> 8; const int combo = v >> 4, s = v & 15, b = combo >> 1, hg = combo & 1;
        const int k2 = iu >> 1; const int qb = (iu & 1) ? (32 * k2 + 31 - s) : (32 * k2 + s);
        const int h = hg * 8 + wave; const int NT = (qb >> 1) + 1;
        const size_t rowbase = (size_t)b * SEQ + (size_t)qb * 32;
        bf16x8 qf[12];
        { const bf16_t* qp = Q + (rowbase + q) * QPITCH + h * 192 + hi * 8;
#pragma unroll
          for (int ds = 0; ds < 12; ++ds) qf[ds] = *(const bf16x8*)(qp + ds * 16); }
        f32x16 o[4];
#pragma unroll
        for (int d = 0; d < 4; ++d)
#pragma unroll
            for (int r = 0; r < 16; ++r) o[d][r] = 0.f;
        float mref = 0.f, lrun = 0.f;
        const bf16_t* Kb = KK + (size_t)b * SEQ * 192; const bf16_t* Vb = VT + (size_t)b * 128 * SEQ;
        u32x4 kr[3], vr[2];
#define ATT_LOAD(t) do { _Pragma("unroll") for (int it = 0; it < 3; ++it) kr[it] = *(const u32x4*)(Kb + (size_t)(t) * 64 * 192 + (size_t)(tid + 512 * it) * 8); \
                         _Pragma("unroll") for (int it = 0; it < 2; ++it) { const int idx = tid + 512 * it; vr[it] = *(const u32x4*)(Vb + (size_t)(idx >> 3) * SEQ + (t) * 64 + (idx & 7) * 8); } } while (0)
#define ATT_STORE(buf) do { _Pragma("unroll") for (int it = 0; it < 3; ++it) { const int idx = tid + 512 * it; *(LAS u32x4*)(lds + (buf) * BUF + (idx / 24) * KPB + (idx % 24) * 16) = kr[it]; } \
                            _Pragma("unroll") for (int it = 0; it < 2; ++it) { const int idx = tid + 512 * it; LAS unsigned char* vd = lds + (buf) * BUF + KBYTES + (idx >> 3) * VPB + (idx & 7) * 16; \
                                *(LAS u32x2*)vd = (u32x2){vr[it].x, vr[it].y}; *(LAS u32x2*)(vd + 8) = (u32x2){vr[it].z, vr[it].w}; } } while (0)
        ATT_LOAD(0); ATT_STORE(0); __syncthreads();
        for (int t = 0; t < NT; ++t) {
            if (t + 1 < NT) ATT_LOAD(t + 1);
            const LAS unsigned char* kb = lds + (t & 1) * BUF; const LAS unsigned char* vb = kb + KBYTES;
            f32x16 p0, p1;
            { const float nm = -mref;
#pragma unroll
              for (int r = 0; r < 16; ++r) { p0[r] = nm; p1[r] = nm; } }
            __builtin_amdgcn_s_setprio(1);
#pragma unroll
            for (int ds = 0; ds < 12; ++ds) {
                const bf16x8 a0 = *(const LAS bf16x8*)(kb + q * KPB + ds * 32 + hi * 16), a1 = *(const LAS bf16x8*)(kb + (q + 32) * KPB + ds * 32 + hi * 16);
                p0 = __builtin_amdgcn_mfma_f32_32x32x16_bf16(a0, qf[ds], p0, 0, 0, 0);
                p1 = __builtin_amdgcn_mfma_f32_32x32x16_bf16(a1, qf[ds], p1, 0, 0, 0);
            }
            __builtin_amdgcn_s_setprio(0);
            if (t == NT - 1) { const int qpos = qb * 32 + q, kbase = t * 64 + 4 * hi;
#pragma unroll
                for (int r = 0; r < 16; ++r) { const int key = kbase + (r & 3) + 8 * (r >> 2); if (key > qpos) p0[r] = -INFINITY; if (key + 32 > qpos) p1[r] = -INFINITY; } }
            float mx = fmaxf(p0[0], p1[0]);
#pragma unroll
            for (int r = 1; r < 16; ++r) mx = fmaxf(mx, fmaxf(p0[r], p1[r]));
            if (__builtin_expect(t == 0 || __any(mx > ATT_THR), 0)) {
                const float rm = fmaxf(mx, shfl_x(mx, lane, 32));
                const float dl = (t == 0) ? rm : fmaxf(rm, 0.f);
                mref += dl;
                const float f = __builtin_amdgcn_exp2f(-dl);
                lrun *= f;
#pragma unroll
                for (int r = 0; r < 16; ++r) { p0[r] -= dl; p1[r] -= dl; }
#pragma unroll
                for (int d = 0; d < 4; ++d)
#pragma unroll
                    for (int r = 0; r < 16; ++r) o[d][r] *= f;
            }
            float rsum = 0.f;
#pragma unroll
            for (int r = 0; r < 16; ++r) { p0[r] = __builtin_amdgcn_exp2f(p0[r]); p1[r] = __builtin_amdgcn_exp2f(p1[r]); rsum += p0[r] + p1[r]; }
            lrun += rsum;
            u32x4 w00, w01, w10, w11;
            w00.x = cvtpk_s(p0[0], p0[1]); w00.y = cvtpk_s(p0[2], p0[3]); w00.z = cvtpk_s(p0[4], p0[5]); w00.w = cvtpk_s(p0[6], p0[7]);
            w01.x = cvtpk_s(p0[8], p0[9]); w01.y = cvtpk_s(p0[10], p0[11]); w01.z = cvtpk_s(p0[12], p0[13]); w01.w = cvtpk_s(p0[14], p0[15]);
            w10.x = cvtpk_s(p1[0], p1[1]); w10.y = cvtpk_s(p1[2], p1[3]); w10.z = cvtpk_s(p1[4], p1[5]); w10.w = cvtpk_s(p1[6], p1[7]);
            w11.x = cvtpk_s(p1[8], p1[9]); w11.y = cvtpk_s(p1[10], p1[11]); w11.z = cvtpk_s(p1[12], p1[13]); w11.w = cvtpk_s(p1[14], p1[15]);
            const bf16x8 pa00 = __builtin_bit_cast(bf16x8, w00), pa01 = __builtin_bit_cast(bf16x8, w01), pa10 = __builtin_bit_cast(bf16x8, w10), pa11 = __builtin_bit_cast(bf16x8, w11);
            __builtin_amdgcn_s_setprio(1);
#pragma unroll
            for (int d = 0; d < 4; ++d) {
                const LAS unsigned char* vp = vb + (d * 32 + q) * VPB + hi * 8;
#define ATT_PV(off, PA) do { const u32x2 lo = *(const LAS u32x2*)(vp + (off) * 2), hh = *(const LAS u32x2*)(vp + (off) * 2 + 16); \
                             const u32x4 av = (u32x4){lo.x, lo.y, hh.x, hh.y}; o[d] = __builtin_amdgcn_mfma_f32_32x32x16_bf16(__builtin_bit_cast(bf16x8, av), PA, o[d], 0, 0, 0); } while (0)
                ATT_PV(0, pa00); ATT_PV(16, pa01); ATT_PV(32, pa10); ATT_PV(48, pa11);
#undef ATT_PV
            }
            __builtin_amdgcn_s_setprio(0);
            if (t + 1 < NT) ATT_STORE((t + 1) & 1);
            __syncthreads();
        }
#undef ATT_LOAD
#undef ATT_STORE
        lrun += shfl_x(lrun, lane, 32);
        const float inv = 1.0f / lrun;
        bf16_t* op = OL + (rowbase + q) * 2048 + h * 128 + 8 * hi;
#pragma unroll
        for (int d = 0; d < 4; ++d)
#pragma unroll
            for (int gp = 0; gp < 2; ++gp) {
                const int A = 2 * gp, B = 2 * gp + 1;
                const unsigned ax = cvt_pk_bf16(o[d][4 * A] * inv, o[d][4 * A + 1] * inv), ay = cvt_pk_bf16(o[d][4 * A + 2] * inv, o[d][4 * A + 3] * inv);
                const unsigned bx = cvt_pk_bf16(o[d][4 * B] * inv, o[d][4 * B + 1] * inv), by = cvt_pk_bf16(o[d][4 * B + 2] * inv, o[d][4 * B + 3] * inv);
                const auto sx = __builtin_amdgcn_permlane32_swap(ax, bx, false, false), sy = __builtin_amdgcn_permlane32_swap(ay, by, false, false);
                u32x4 w; w.x = sx[0]; w.y = sy[0]; w.z = sx[1]; w.w = sy[1];
                *(u32x4*)(op + d * 32 + 16 * gp) = w; }
    }
}

#define GEMM_RUN(EPI_T, epi, Aptr, Bptr, N_, K_, lda_, ldb_, astep_) do { const WMap mp_ = ldmap(lds); pg8::Gemm g_{(const bf16_t*)(Aptr), (const bf16_t*)(Bptr)}; \
    pg8::StaticOrder S_; S_.init(M, (N_), fresh_s(G), fresh_s(mp_.local ? mp_.rank * 8 + mp_.grp : ((G == 256) ? (int)((blockIdx.x * 37u) & 255u) : (int)blockIdx.x))); pg8::gemm_phase<EPI_T, true, true, (K_), (lda_), (ldb_), (astep_)>(lds, g_, S_, (epi)); } while (0)

#define WSP(T, off) ((T*)(PA(ws) + (off)))
#define MODL(li, off) (WSP(float, OFF_MOD) + (size_t)(li) * BATCH * MODW + (off))

#define GSYNC_G() xcd_barrier(WSP(unsigned, OFF_BAR), (volatile LAS unsigned*)(lds + 131072 + 64), false)
#define GSYNC_L() xcd_barrier(WSP(unsigned, OFF_BAR), (volatile LAS unsigned*)(lds + 131072 + 64), true)
#define GEMM_RUN_X(EPI_T, epi, Aptr, Bptr, N_, K_, lda_, ldb_, astep_, PMX_) do { const WMap mp_ = ldmap(lds); pg8::Gemm g_{(const bf16_t*)(Aptr), (const bf16_t*)(Bptr)}; \
    pg8::StaticOrder S_; S_.init(M, (N_), fresh_s(G), fresh_s(mp_.local ? mp_.rank * 8 + mp_.grp : ((G == 256) ? (int)((blockIdx.x * 37u) & 255u) : (int)blockIdx.x))); S_.pmx = (PMX_); pg8::gemm_phase<EPI_T, true, true, (K_), (lda_), (ldb_), (astep_)>(lds, g_, S_, (epi)); } while (0)
template <int li> __device__ __forceinline__ void layer_phases(LAS unsigned char* lds, int G) {
        constexpr int kind = li % 3;
        if constexpr (kind == 0) {
            constexpr int j = li / 3;
            pool_pre_phase<li == 0>(lds, (li == 0) ? (const void*)PA(x) : (const void*)WSP(bf16_t, OFF_XB), WSP(bf16_t, OFF_H), WSP(bf16_t, OFF_XB), PA(norm_mix_g) + li * DM, MODL(li, 0), MODL(li, DM), G, ldmap(lds));
            GSYNC_L();
            { pg8::EpiRes<false> e{WSP(bf16_t, OFF_XB), WSP(bf16_t, OFF_XB), MODL(li, 2 * DM), PA(pool_scale) + j * DM};
              GEMM_RUN(pg8::EpiRes<false>, e, WSP(bf16_t, OFF_H), WSP(bf16_t, OFF_POOLT) + (size_t)j * 1024 * 256, DM, 256, DM, 256, 256); }
            GSYNC_L();
        } else if constexpr (kind == 1) {
            norm_mod_phase<false>(WSP(bf16_t, OFF_XB), WSP(bf16_t, OFF_H), PA(norm_mix_g) + li * DM, MODL(li, 0), MODL(li, DM), G, ldmap(lds));
            GSYNC_L();
            { pg8::EpiBf16<1> e{(bf16_t*)PA(out), 2048}; GEMM_RUN(pg8::EpiBf16<1>, e, WSP(bf16_t, OFF_H), WSP(bf16_t, OFF_SGUIN), 2048, DM, DM, DM, 0); }
            GSYNC_L();
            sgu_spatial_phase(lds, (const bf16_t*)PA(out), WSP(bf16_t, OFF_WSB), PA(sgu_ln_g), PA(sgu_ln_b), PA(sgu_b_s), WSP(bf16_t, OFF_H), G, ldmap(lds));
            GSYNC_L();
            { pg8::EpiRes<false> e{WSP(bf16_t, OFF_XB), WSP(bf16_t, OFF_XB), MODL(li, 2 * DM), nullptr}; GEMM_RUN(pg8::EpiRes<false>, e, WSP(bf16_t, OFF_H), WSP(bf16_t, OFF_SGUOUT), DM, DM, DM, DM, 0); }
            GSYNC_L();
        } else {
            norm_mod_phase<false>(WSP(bf16_t, OFF_XB), WSP(bf16_t, OFF_H), PA(norm_mix_g) + li * DM, MODL(li, 0), MODL(li, DM), G, ldmap(lds));
            GSYNC_L();
            { pg8::EpiF32<0> e{WSP(float, OFF_LAT), LATPITCH, nullptr, nullptr, nullptr}; GEMM_RUN(pg8::EpiF32<0>, e, WSP(bf16_t, OFF_H), WSP(bf16_t, OFF_LATT), 512, DM, DM, DM, 0); }
            GSYNC_L();
            lat_norm_phase(WSP(float, OFF_LAT), WSP(float, OFF_CS), PA(mla_q_norm_g), PA(mla_kv_norm_g), WSP(bf16_t, OFF_CQ), WSP(bf16_t, OFF_KK), WSP(bf16_t, OFF_VT), G, ldmap(lds));
            GSYNC_L();
            { pg8::EpiQ e{WSP(bf16_t, OFF_BIG), WSP(float, OFF_CS), 0.07216878364870323f * 1.4426950408889634f}; GEMM_RUN(pg8::EpiQ, e, WSP(bf16_t, OFF_CQ), WSP(bf16_t, OFF_QABS), 3072, 256, 256, 256, 0); }
            GSYNC_L();
            { const WMap mpa = ldmap(lds); const int vcu = mpa.local ? mpa.grp * 32 + mpa.rank : ((G % 8 == 0) ? ((int)blockIdx.x % 8) * (G / 8) + (int)blockIdx.x / 8 : (int)blockIdx.x);
              attn_phase(lds, WSP(bf16_t, OFF_BIG), WSP(bf16_t, OFF_KK), WSP(bf16_t, OFF_VT), (bf16_t*)PA(out), vcu, G); }
            GSYNC_L();
            { pg8::EpiRes<false> e{WSP(bf16_t, OFF_XB), WSP(bf16_t, OFF_XB), MODL(li, 2 * DM), nullptr}; GEMM_RUN(pg8::EpiRes<false>, e, (const bf16_t*)PA(out), WSP(bf16_t, OFF_OABS), DM, 2048, 2048, 2048, 0); }
            GSYNC_L();
        }
        norm_mod_phase<false>(WSP(bf16_t, OFF_XB), WSP(bf16_t, OFF_H), PA(norm_mlp_g) + li * DM, MODL(li, 3 * DM), MODL(li, 4 * DM), G, ldmap(lds));
        GSYNC_L();
        { pg8::EpiBf16<2> e{WSP(bf16_t, OFF_BIG), FF}; GEMM_RUN(pg8::EpiBf16<2>, e, WSP(bf16_t, OFF_H), WSP(bf16_t, OFF_W1T) + (size_t)li * DM * FF, FF, DM, DM, DM, 0); }
        GSYNC_L();
        { pg8::EpiRes<false> e{WSP(bf16_t, OFF_XB), WSP(bf16_t, OFF_XB), MODL(li, 5 * DM), nullptr}; GEMM_RUN_X(pg8::EpiRes<false>, e, WSP(bf16_t, OFF_BIG), WSP(bf16_t, OFF_W2T) + (size_t)li * DM * FF, DM, FF, FF, FF, 0, 8); }
        GSYNC_L();
}

__global__ void __launch_bounds__(NTHREADS, 2) fwd_megakernel(Params p) {
    extern __shared__ __attribute__((aligned(16))) unsigned char lds_raw[];
    LAS unsigned char* lds = (LAS unsigned char*)lds_raw;
    cg::grid_group grid = cg::this_grid();
    const int G = gridDim.x;
    const int tid0 = fresh_tid();
    if (tid0 < 64) ((LAS unsigned*)(lds + 131072))[tid0] = 0u;
    if (blockIdx.x == 0) { unsigned* bw = WSP(unsigned, OFF_BAR); for (int i = tid0; i < XCD_BAR_WORDS; i += NTHREADS) bw[i] = 0u; }
    __syncthreads();
    prologue(lds, G);
    grid.sync();
    { volatile LAS unsigned* st = (volatile LAS unsigned*)(lds + 131072 + 64); unsigned* bar = WSP(unsigned, OFF_BAR);
      if (threadIdx.x == 0) { const unsigned x = xb_xcc_id(); st[3] = x; st[4] = xb_add(bar + XB_XCNT(x), 1u); }
      xcd_barrier(bar, st, false);
      if (threadIdx.x == 0) { bool ok = (G == 256) && st[1] == 8u && st[3] < 8u;
#pragma unroll
          for (unsigned j = 0; j < 8; ++j) ok = ok && (xb_ld(bar + XB_XCNT(j)) == 32u);
          st[2] = ok ? 1u : 0u; }
      __syncthreads(); }

    layer_phases<0>(lds, G);
    layer_phases<1>(lds, G);
    layer_phases<2>(lds, G);
    layer_phases<3>(lds, G);
    final_norm_phase(WSP(bf16_t, OFF_XB), PA(out), PA(final_g), G, ldmap(lds));
}

extern "C" void kernel_launch(void* const* d_in, const int* in_sizes, int n_in, void* d_out, int out_size, void* d_ws, size_t ws_size, hipStream_t stream) {
    static int grid = 0;
    if (grid == 0) {
        if (n_in != 24 || in_sizes[0] != M * DM || out_size != M * DM || ws_size < WS_NEED) { fprintf(stderr, "kernel_launch: unexpected shapes (n_in %d, in0 %d, out %d, ws %zu)\n", n_in, n_in > 0 ? in_sizes[0] : -1, out_size, ws_size); grid = -1; return; }
        int dev = 0, cus = 0, per_cu = 0;
        hipGetDevice(&dev); hipDeviceGetAttribute(&cus, hipDeviceAttributeMultiprocessorCount, dev);
        if (hipFuncSetAttribute((const void*)fwd_megakernel, hipFuncAttributeMaxDynamicSharedMemorySize, LDS_BYTES) != hipSuccess) { fprintf(stderr, "kernel_launch: hipFuncSetAttribute failed\n"); grid = -1; return; }
        if (hipOccupancyMaxActiveBlocksPerMultiprocessor(&per_cu, (const void*)fwd_megakernel, NTHREADS, LDS_BYTES) != hipSuccess || per_cu < 1) { fprintf(stderr, "kernel_launch: occupancy query says %d\n", per_cu); per_cu = 1; }
        (void)hipGetLastError();
        grid = cus * 1;
    }
    if (grid < 0) return;
    Params p{};
    p.x = (const float*)d_in[0]; p.c = (const float*)d_in[1]; p.pos = (const int*)d_in[2]; p.ada_w = (const float*)d_in[3]; p.ada_b = (const float*)d_in[4];
    p.norm_mix_g = (const float*)d_in[5]; p.norm_mlp_g = (const float*)d_in[6]; p.pool_w = (const float*)d_in[7]; p.pool_scale = (const float*)d_in[8];
    p.sgu_w_in = (const float*)d_in[9]; p.sgu_ln_g = (const float*)d_in[10]; p.sgu_ln_b = (const float*)d_in[11]; p.sgu_w_s = (const float*)d_in[12]; p.sgu_b_s = (const float*)d_in[13]; p.sgu_w_out = (const float*)d_in[14];
    p.mla_w_dq_dkv = (const float*)d_in[15]; p.mla_q_norm_g = (const float*)d_in[16]; p.mla_kv_norm_g = (const float*)d_in[17]; p.mla_w_uq = (const float*)d_in[18]; p.mla_w_ukv = (const float*)d_in[19]; p.mla_w_o = (const float*)d_in[20];
    p.mlp_w1 = (const float*)d_in[21]; p.mlp_w2 = (const float*)d_in[22]; p.final_g = (const float*)d_in[23];
    p.out = (float*)d_out; p.ws = (unsigned char*)d_ws;
    void* args[] = {&p};
    hipError_t e = hipLaunchCooperativeKernel((const void*)fwd_megakernel, dim3(grid), dim3(NTHREADS), args, LDS_BYTES, stream);
    if (e != hipSuccess) fprintf(stderr, "kernel_launch: cooperative launch failed: %s (grid %d)\n", hipGetErrorString(e), grid);
}
```

```cpp
#include <hip/hip_runtime.h>
#include <hip/hip_cooperative_groups.h>
#include <cstdio>
#include <cstdint>
#include <cstddef>
namespace cg = cooperative_groups;

#define LAS __attribute__((address_space(3)))
typedef unsigned short bf16_t;
typedef short bf16x8 __attribute__((ext_vector_type(8)));
typedef float f32x4 __attribute__((ext_vector_type(4)));
typedef float f32x2 __attribute__((ext_vector_type(2)));
typedef float f32x16 __attribute__((ext_vector_type(16)));
typedef unsigned u32x4 __attribute__((ext_vector_type(4)));
typedef unsigned u32x2 __attribute__((ext_vector_type(2)));

constexpr int BATCH = 8, SEQ = 4096, DM = 1024, FF = 4096, M = BATCH * SEQ, DEPTH = 4;
constexpr int MODW = 6 * DM;
constexpr float RMS_EPS = 1e-6f, LN_EPS = 1e-5f;
constexpr int NTHREADS = 512, NWAVES = 8;
constexpr int LDS_BYTES = 147456;

constexpr size_t MiB = 1u << 20;
constexpr size_t OFF_MOD = 0;
constexpr size_t OFF_BAR = 896 * 1024;
constexpr size_t OFF_CS = 1 * MiB;
constexpr size_t OFF_W1T = 9 * MiB;
constexpr size_t OFF_W2T = 41 * MiB;
constexpr size_t OFF_SGUIN = 73 * MiB;
constexpr size_t OFF_SGUOUT = 77 * MiB;
constexpr size_t OFF_WSB = 79 * MiB;
constexpr size_t OFF_LATT = 80 * MiB;
constexpr size_t OFF_QABS = 81 * MiB;
constexpr size_t OFF_OABS = 83 * MiB;
constexpr size_t OFF_POOLT = 87 * MiB;
constexpr size_t OFF_CQ = 88 * MiB;
constexpr size_t OFF_KK = 104 * MiB;
constexpr size_t OFF_VT = 116 * MiB;
constexpr size_t OFF_BIG = 128 * MiB;
constexpr size_t OFF_LAT = OFF_BIG + 6144;
constexpr int QPITCH = 4096, LATPITCH = 2048;
constexpr size_t OFF_H = 384 * MiB;
constexpr size_t OFF_OL = OFF_BIG + 192 * MiB;
constexpr size_t OFF_XB = 448 * MiB;
constexpr size_t WS_NEED = 512 * MiB;

__device__ __forceinline__ unsigned cvt_pk_bf16(float lo, float hi) { unsigned r; asm volatile("v_cvt_pk_bf16_f32 %0, %1, %2" : "=v"(r) : "v"(lo), "v"(hi)); return r; }
typedef __bf16 bf16x2_t __attribute__((ext_vector_type(2)));
__device__ __forceinline__ unsigned cvtpk_s(float lo, float hi) { f32x2 v = {lo, hi}; bf16x2_t b = __builtin_convertvector(v, bf16x2_t); return __builtin_bit_cast(unsigned, b); }
__device__ __forceinline__ float bf2f(unsigned short u) { return __uint_as_float(((unsigned)u) << 16); }
__device__ __forceinline__ float bflo(unsigned u) { return __uint_as_float(u << 16); }
__device__ __forceinline__ float bfhi(unsigned u) { return __uint_as_float(u & 0xffff0000u); }
__device__ __forceinline__ float shfl_x(float v, int lane, int o) { return __int_as_float(__builtin_amdgcn_ds_bpermute((lane ^ o) << 2, __float_as_int(v))); }
__device__ __forceinline__ float wave_sum(float v, int lane) {
#pragma unroll
    for (int o = 1; o < 64; o <<= 1) v += shfl_x(v, lane, o);
    return v;
}
__device__ __forceinline__ int fresh_s(int v) { asm volatile("" : "+s"(v)); return v; }

__device__ __forceinline__ int fresh_tid() { int t = threadIdx.x; asm volatile("" : "+v"(t)); return t; }
template <bool XF32> __device__ __forceinline__ f32x4 ldx4(const void* base, size_t i4) {
    if constexpr (XF32) return ((const f32x4*)base)[i4];
    else { const u32x2 r = ((const u32x2*)base)[i4]; return (f32x4){bflo(r.x), bfhi(r.x), bflo(r.y), bfhi(r.y)}; }
}
template <bool XF32> __device__ __forceinline__ f32x2 ldx2(const void* base, size_t i2) {
    if constexpr (XF32) return ((const f32x2*)base)[i2];
    else { const unsigned r = ((const unsigned*)base)[i2]; return (f32x2){bflo(r), bfhi(r)}; }
}
namespace pg8 {
constexpr int BM = 256, BK = 64, HALF = 128, HTB = HALF * BK * 2, STAGE_BYTES = 8 * HTB, NXCD = 8, WGM = 8;
__host__ __device__ __forceinline__ int lds_byte(int r, int c) { const int st = (r >> 4) * 2 + (c >> 5), rr = r & 15, cc = c & 31, ob = rr * 64 + cc * 2; return st * 1024 + (ob ^ (((ob >> 9) & 1) << 5)); }
__host__ __device__ __forceinline__ void stage_rc(int b, int& R, int& C) { const int st = b / 1024, sb = b % 1024, swz = sb ^ (((sb >> 9) & 1) << 5); R = (st >> 1) * 16 + swz / 64; C = (st & 1) * 32 + (swz % 64) / 2; }
__host__ __device__ __forceinline__ int perm32(int rho) { const int n = rho >> 4, i = rho & 15; return 8 * (i >> 2) + 4 * n + (i & 3); }

struct Unit { int pm, pn; };
struct Gemm { const bf16_t* A; const bf16_t* Bt; };

struct StaticOrder {
    int nM, nN, nwg, G, c, pmx = 0;
    __device__ void init(int M_, int N_, int G_, int c_) { nM = M_ / BM; nN = N_ / BM; nwg = nM * nN; G = G_; c = c_; }
    __device__ bool next(int i, Unit& u) const {
        const long L = (long)i * G + c; if (L >= nwg) return false;
        int wgid = (int)L; { const int q = nwg / NXCD, r = nwg % NXCD, xcd = wgid % NXCD, off = wgid / NXCD; wgid = (xcd < r ? xcd * (q + 1) : r * (q + 1) + (xcd - r) * q) + off; }
        const int nig = WGM * nN, gid = wgid / nig, fm = gid * WGM, gsz = (nM - fm) < WGM ? (nM - fm) : WGM;
        u.pm = (fm + ((wgid % nig) % gsz)) ^ pmx; u.pn = (wgid % nig) / gsz; return true;
    }
};

__device__ __forceinline__ f32x2 gelu_pk(f32x2 v) {
    const f32x2 av = __builtin_elementwise_abs(v), d = av * 0.2316418882f + 1.0f;
    f32x2 t; t.x = __builtin_amdgcn_rcpf(d.x); t.y = __builtin_amdgcn_rcpf(d.y);
    f32x2 q = t * 0.5307027145f + (-0.7265760135f); q = q * t + 0.7107068705f; q = q * t + (-0.142248368f); q = q * t + 0.127414796f; q = q * t;
    const f32x2 s = (v * v) * (-0.72134752044f);
    f32x2 e; e.x = __builtin_amdgcn_exp2f(s.x); e.y = __builtin_amdgcn_exp2f(s.y);
    const f32x2 m = v * (q * e), r = v - m;
    f32x2 o; o.x = v.x < 0.f ? m.x : r.x; o.y = v.y < 0.f ? m.y : r.y; return o;
}

template <int ACT  > struct EpiBf16 {
    static constexpr bool PERM = true;
    bf16_t* O; int ldc;
    __device__ __forceinline__ void operator()(const f32x4 (&acc)[2][2][4][2], const Unit& u, int wr, int wc, int fr, int fq) const {
        const int row0 = u.pm * BM + wr * 64 + fr; const int col0 = u.pn * BM + wc * 32 + 8 * fq;
#pragma unroll
        for (int ai = 0; ai < 2; ++ai)
#pragma unroll
            for (int m = 0; m < 4; ++m) { bf16_t* rowp = O + (size_t)(row0 + ai * HALF + m * 16) * ldc + col0;
#pragma unroll
                for (int bj = 0; bj < 2; ++bj) { f32x4 v0 = acc[ai][bj][m][0], v1 = acc[ai][bj][m][1];
                    if (ACT == 1) { f32x2 a = gelu_pk((f32x2){v0[0], v0[1]}), b = gelu_pk((f32x2){v0[2], v0[3]}), c = gelu_pk((f32x2){v1[0], v1[1]}), d = gelu_pk((f32x2){v1[2], v1[3]});
                        v0 = (f32x4){a.x, a.y, b.x, b.y}; v1 = (f32x4){c.x, c.y, d.x, d.y}; }
                    if (ACT == 2) { v0 = __builtin_elementwise_max(v0, (f32x4){0.f, 0.f, 0.f, 0.f}); v1 = __builtin_elementwise_max(v1, (f32x4){0.f, 0.f, 0.f, 0.f}); v0 = v0 * v0; v1 = v1 * v1; }
                    u32x4 w; w.x = cvt_pk_bf16(v0[0], v0[1]); w.y = cvt_pk_bf16(v0[2], v0[3]); w.z = cvt_pk_bf16(v1[0], v1[1]); w.w = cvt_pk_bf16(v1[2], v1[3]);
                    *(u32x4*)(rowp + bj * HALF) = w; } }
    }
};
struct EpiQ {
    static constexpr bool PERM = true;
    bf16_t* O; const float* cs; float qscale;
    __device__ __forceinline__ void operator()(const f32x4 (&acc)[2][2][4][2], const Unit& u, int wr, int wc, int fr, int fq) const {
        const int row0 = u.pm * BM + wr * 64 + fr;
#pragma unroll
        for (int bj = 0; bj < 2; ++bj) {
            const int c0 = u.pn * BM + bj * HALF + wc * 32 + 8 * fq; const int e = c0 % 192; const bool rope = e >= 128; const int j0 = rope ? ((e - 128) >> 1) : 0;
#pragma unroll
            for (int ai = 0; ai < 2; ++ai)
#pragma unroll
                for (int m = 0; m < 4; ++m) { const int row = row0 + ai * HALF + m * 16;
                    f32x4 v0 = acc[ai][bj][m][0] * qscale, v1 = acc[ai][bj][m][1] * qscale;
                    if (rope) { const f32x4 co = *(const f32x4*)(cs + (size_t)row * 64 + j0), si = *(const f32x4*)(cs + (size_t)row * 64 + 32 + j0);
                        f32x4 r0, r1;
                        r0[0] = v0[0] * co[0] - v0[1] * si[0]; r0[1] = v0[1] * co[0] + v0[0] * si[0];
                        r0[2] = v0[2] * co[1] - v0[3] * si[1]; r0[3] = v0[3] * co[1] + v0[2] * si[1];
                        r1[0] = v1[0] * co[2] - v1[1] * si[2]; r1[1] = v1[1] * co[2] + v1[0] * si[2];
                        r1[2] = v1[2] * co[3] - v1[3] * si[3]; r1[3] = v1[3] * co[3] + v1[2] * si[3];
                        v0 = r0; v1 = r1; }
                    u32x4 w; w.x = cvt_pk_bf16(v0[0], v0[1]); w.y = cvt_pk_bf16(v0[2], v0[3]); w.z = cvt_pk_bf16(v1[0], v1[1]); w.w = cvt_pk_bf16(v1[2], v1[3]);
                    *(u32x4*)(O + (size_t)row * QPITCH + c0) = w; }
        }
    }
};
template <bool XF32> struct EpiRes {
    static constexpr bool PERM = true;
    bf16_t* out; const void* xin; const float* gate; const float* scale;
    __device__ __forceinline__ void operator()(const f32x4 (&acc)[2][2][4][2], const Unit& u, int wr, int wc, int fr, int fq) const {
        const int row0 = u.pm * BM + wr * 64 + fr; const int col0 = u.pn * BM + wc * 32 + 8 * fq;
        const float* gp = gate + (size_t)(u.pm >> 4) * MODW;
#pragma unroll
        for (int bj = 0; bj < 2; ++bj) { const int c = col0 + bj * HALF;
            f32x4 g0 = *(const f32x4*)(gp + c), g1 = *(const f32x4*)(gp + c + 4);
            if (scale) { g0 = g0 * *(const f32x4*)(scale + c); g1 = g1 * *(const f32x4*)(scale + c + 4); }
#pragma unroll
            for (int ai = 0; ai < 2; ++ai)
#pragma unroll
                for (int m = 0; m < 4; ++m) { const size_t off = (size_t)(row0 + ai * HALF + m * 16) * DM + c;
                    const f32x4 x0 = ldx4<XF32>(xin, off / 4), x1 = ldx4<XF32>(xin, off / 4 + 1);
                    const f32x4 v0 = x0 + g0 * acc[ai][bj][m][0], v1 = x1 + g1 * acc[ai][bj][m][1];
                    u32x4 w; w.x = cvt_pk_bf16(v0[0], v0[1]); w.y = cvt_pk_bf16(v0[2], v0[3]); w.z = cvt_pk_bf16(v1[0], v1[1]); w.w = cvt_pk_bf16(v1[2], v1[3]);
                    *(u32x4*)(out + off) = w; } }
    }
};
template <int MODE> struct EpiF32 {
    static constexpr bool PERM = false;
    float* out; int ldc; const float* xin; const float* gate; const float* scale;
    __device__ __forceinline__ void operator()(const f32x4 (&acc)[2][2][4][2], const Unit& u, int wr, int wc, int fr, int fq) const {
        const int row0 = u.pm * BM + wr * 64 + fr; const int col0 = u.pn * BM + wc * 32 + 4 * fq;
        f32x4 gv[2][2];
        if (MODE == 1) { const float* gp = gate + (size_t)(u.pm >> 4) * MODW;
#pragma unroll
            for (int bj = 0; bj < 2; ++bj)
#pragma unroll
                for (int n = 0; n < 2; ++n) { const int c = col0 + bj * HALF + n * 16; f32x4 g = *(const f32x4*)(gp + c); if (scale) g = g * *(const f32x4*)(scale + c); gv[bj][n] = g; } }
#pragma unroll
        for (int ai = 0; ai < 2; ++ai)
#pragma unroll
            for (int m = 0; m < 4; ++m) { const size_t off = (size_t)(row0 + ai * HALF + m * 16) * ldc + col0;
#pragma unroll
                for (int bj = 0; bj < 2; ++bj)
#pragma unroll
                    for (int n = 0; n < 2; ++n) { f32x4 v = acc[ai][bj][m][n];
                        if (MODE == 1) { const f32x4 xi = *(const f32x4*)(xin + off + bj * HALF + n * 16); v = xi + gv[bj][n] * v; }
                        *(f32x4*)(out + off + bj * HALF + n * 16) = v; } }
    }
};

template <class Epi, bool ALIGN_EPI, bool SP2, int K, int LDA, int LDB, int ASTEP>
__device__ __forceinline__ void gemm_phase(LAS unsigned char* lds, const Gemm g, const StaticOrder& S, const Epi& E) {
    const int tid = fresh_tid(), wid = __builtin_amdgcn_readfirstlane(tid >> 6), lane = tid & 63, wr = wid >> 2, wc = wid & 3, fr = lane & 15, fq = lane >> 4;
    constexpr int nt = K / BK;
    unsigned voffA[2], voffB[2];
#pragma unroll
    for (int i = 0; i < 2; ++i) { int R, C; stage_rc(tid * 16 + i * 8192, R, C); const int Rb = Epi::PERM ? ((R & ~31) + perm32(R & 31)) : R;
        voffA[i] = (unsigned)(R * LDA + C) * 2u; voffB[i] = (unsigned)(Rb * LDB + C) * 2u; }
    constexpr size_t kstep = (size_t)(BK * 2);
    constexpr size_t hstepA = (size_t)HALF * LDA * 2, hstepB = (size_t)HALF * LDB * 2;
    constexpr size_t tstepA = 2 * hstepA, tstepB = 2 * hstepB, pnA = (size_t)ASTEP * 2;
    const unsigned ldsw = (unsigned)wid * 1024u;
    const int aoff = lds_byte(wr * 64 + fr, fq * 8), boff = lds_byte(wc * 32 + fr, fq * 8);
#define PG8_SA(b, h) (((b) * 2 + (h)) * HTB)
#define PG8_SB(b, h) ((4 + (b) * 2 + (h)) * HTB)
#define PG8_STAGE(bufoff, gbase, voff) do { _Pragma("unroll") for (int _i = 0; _i < 2; ++_i) \
        __builtin_amdgcn_global_load_lds((const unsigned*)((const char*)(gbase) + (voff)[_i]), (LAS unsigned*)(lds + (bufoff) + ldsw + _i * 8192), 16, 0, 0); } while (0)
#define PG8_LDA(dst, b, h) do { _Pragma("unroll") for (int m = 0; m < 4; ++m) _Pragma("unroll") for (int k = 0; k < 2; ++k) dst[m][k] = *(const LAS bf16x8*)(lds + PG8_SA(b, h) + aoff + m * 2048 + k * 1024); } while (0)
#define PG8_LDB(dst, b, h) do { _Pragma("unroll") for (int n = 0; n < 2; ++n) _Pragma("unroll") for (int k = 0; k < 2; ++k) dst[n][k] = *(const LAS bf16x8*)(lds + PG8_SB(b, h) + boff + n * 2048 + k * 1024); } while (0)
#define PG8_MMA(ai, bj, At, Bt) do { __builtin_amdgcn_s_setprio(1); _Pragma("unroll") for (int m = 0; m < 4; ++m) _Pragma("unroll") for (int n = 0; n < 2; ++n) _Pragma("unroll") for (int k = 0; k < 2; ++k) \
        acc[ai][bj][m][n] = __builtin_amdgcn_mfma_f32_16x16x32_bf16(Bt[n][k], At[m][k], acc[ai][bj][m][n], 0, 0, 0); __builtin_amdgcn_s_setprio(0); } while (0)
#define PG8_WAIT_V(n) asm volatile("s_waitcnt vmcnt(" #n ")" ::: "memory")
#define PG8_WAIT_L(n) asm volatile("s_waitcnt lgkmcnt(" #n ")" ::: "memory")
#define PG8_BAR __builtin_amdgcn_s_barrier()
#define PG8_SCHED __builtin_amdgcn_sched_barrier(0)
    Unit cur, nxt; int ui = 0;
    if (!S.next(0, cur)) return;
    f32x4 acc[2][2][4][2];
#pragma unroll
    for (int a = 0; a < 2; ++a)
#pragma unroll
        for (int b = 0; b < 2; ++b)
#pragma unroll
            for (int m = 0; m < 4; ++m)
#pragma unroll
                for (int n = 0; n < 2; ++n) acc[a][b][m][n] = (f32x4){0.f, 0.f, 0.f, 0.f};
    bf16x8 At[4][2], B0[2][2], B1[2][2];
    const char* cA = (const char*)g.A + (size_t)cur.pm * tstepA + (size_t)cur.pn * pnA; const char* cB = (const char*)g.Bt + (size_t)cur.pn * tstepB;
    if constexpr (SP2) {
        PG8_STAGE(PG8_SB(0, 0), cB, voffB); PG8_STAGE(PG8_SB(0, 1), cB + hstepB, voffB); PG8_STAGE(PG8_SA(0, 0), cA, voffA); PG8_STAGE(PG8_SA(0, 1), cA + hstepA, voffA);
        if (wr == 1) PG8_BAR;
        PG8_WAIT_V(2); PG8_BAR;
        PG8_STAGE(PG8_SB(1, 0), cB + kstep, voffB); PG8_STAGE(PG8_SA(1, 0), cA + kstep, voffA); PG8_STAGE(PG8_SB(1, 1), cB + hstepB + kstep, voffB);
        PG8_WAIT_V(6); PG8_BAR;
    } else {
        PG8_STAGE(PG8_SB(0, 0), cB, voffB); PG8_STAGE(PG8_SA(0, 0), cA, voffA); PG8_STAGE(PG8_SB(0, 1), cB + hstepB, voffB); PG8_STAGE(PG8_SA(0, 1), cA + hstepA, voffA);
        if (wr == 1) PG8_BAR;
        PG8_WAIT_V(4); PG8_BAR;
        PG8_STAGE(PG8_SB(1, 0), cB + kstep, voffB); PG8_STAGE(PG8_SA(1, 0), cA + kstep, voffA); PG8_STAGE(PG8_SB(1, 1), cB + hstepB + kstep, voffB);
        PG8_WAIT_V(6); PG8_BAR;
    }
    for (;;) {
        const bool has_next = S.next(ui + 1, nxt);
        const char* nA = has_next ? (const char*)g.A + (size_t)nxt.pm * tstepA + (size_t)nxt.pn * pnA : cA; const char* nB = has_next ? (const char*)g.Bt + (size_t)nxt.pn * tstepB : cB;
        for (int t = 0; t < nt; t += 2) {
            const bool last = (t == nt - 2);
            const char* a1 = cA + (size_t)(t + 1) * kstep;
            const char* a2 = last ? nA : cA + (size_t)(t + 2) * kstep; const char* b2 = last ? nB : cB + (size_t)(t + 2) * kstep;
            const char* a3 = a2 + kstep; const char* b3 = b2 + kstep;
            if constexpr (SP2) {
            PG8_LDB(B0, 0, 0); PG8_LDB(B1, 0, 1); PG8_SCHED; PG8_LDA(At, 0, 0); PG8_STAGE(PG8_SA(1, 1), a1 + hstepA, voffA);
            PG8_WAIT_V(8); PG8_WAIT_L(0); PG8_BAR; PG8_MMA(0, 0, At, B0); PG8_MMA(0, 1, At, B1); PG8_BAR; PG8_SCHED;
            PG8_LDA(At, 0, 1); PG8_STAGE(PG8_SB(0, 0), b2, voffB); PG8_STAGE(PG8_SB(0, 1), b2 + hstepB, voffB); PG8_STAGE(PG8_SA(0, 0), a2, voffA);
            PG8_WAIT_V(8); PG8_WAIT_L(0); PG8_BAR; PG8_MMA(1, 0, At, B0); PG8_MMA(1, 1, At, B1); PG8_BAR; PG8_SCHED;
            PG8_LDB(B0, 1, 0); PG8_LDB(B1, 1, 1); PG8_SCHED; PG8_LDA(At, 1, 0); PG8_STAGE(PG8_SA(0, 1), a2 + hstepA, voffA);
            PG8_WAIT_V(8); PG8_WAIT_L(0); PG8_BAR; PG8_MMA(0, 0, At, B0); PG8_MMA(0, 1, At, B1); PG8_BAR; PG8_SCHED;
            PG8_LDA(At, 1, 1); PG8_STAGE(PG8_SB(1, 0), b3, voffB); PG8_STAGE(PG8_SB(1, 1), b3 + hstepB, voffB); PG8_STAGE(PG8_SA(1, 0), a3, voffA);
            PG8_WAIT_V(8); PG8_WAIT_L(0); PG8_BAR; PG8_MMA(1, 0, At, B0); PG8_MMA(1, 1, At, B1); PG8_BAR; PG8_SCHED;
            } else {
            PG8_LDB(B0, 0, 0); PG8_SCHED; PG8_LDA(At, 0, 0); PG8_STAGE(PG8_SA(1, 1), a1 + hstepA, voffA);
            PG8_WAIT_L(8); PG8_BAR; PG8_WAIT_L(0); PG8_MMA(0, 0, At, B0); PG8_BAR; PG8_SCHED;
            PG8_LDB(B1, 0, 1); PG8_STAGE(PG8_SB(0, 0), b2, voffB);
            PG8_BAR; PG8_WAIT_L(0); PG8_MMA(0, 1, At, B1); PG8_BAR;
            PG8_LDA(At, 0, 1); PG8_STAGE(PG8_SA(0, 0), a2, voffA);
            PG8_BAR; PG8_WAIT_L(0); PG8_MMA(1, 0, At, B0); PG8_BAR; PG8_SCHED;
            PG8_STAGE(PG8_SB(0, 1), b2 + hstepB, voffB);
            PG8_WAIT_V(6); PG8_BAR; PG8_MMA(1, 1, At, B1); PG8_BAR;
            PG8_LDB(B0, 1, 0); PG8_SCHED; PG8_LDA(At, 1, 0); PG8_STAGE(PG8_SA(0, 1), a2 + hstepA, voffA);
            PG8_WAIT_L(8); PG8_BAR; PG8_WAIT_L(0); PG8_MMA(0, 0, At, B0); PG8_BAR; PG8_SCHED;
            PG8_LDB(B1, 1, 1); PG8_STAGE(PG8_SB(1, 0), b3, voffB);
            PG8_BAR; PG8_WAIT_L(0); PG8_MMA(0, 1, At, B1); PG8_BAR;
            PG8_LDA(At, 1, 1); PG8_STAGE(PG8_SA(1, 0), a3, voffA);
            PG8_BAR; PG8_WAIT_L(0); PG8_MMA(1, 0, At, B0); PG8_BAR; PG8_SCHED;
            PG8_STAGE(PG8_SB(1, 1), b3 + hstepB, voffB);
            PG8_WAIT_V(6); PG8_BAR; PG8_MMA(1, 1, At, B1); PG8_BAR;
            }
        }
        if constexpr (ALIGN_EPI) { if (wr == 0) PG8_BAR; }
        { const int t2 = fresh_tid(), l2 = t2 & 63, w2 = __builtin_amdgcn_readfirstlane(t2 >> 6); E(acc, cur, w2 >> 2, w2 & 3, l2 & 15, l2 >> 4); }
        if (!has_next) break;
#pragma unroll
        for (int a = 0; a < 2; ++a)
#pragma unroll
            for (int b = 0; b < 2; ++b)
#pragma unroll
                for (int m = 0; m < 4; ++m)
#pragma unroll
                    for (int n = 0; n < 2; ++n) acc[a][b][m][n] = (f32x4){0.f, 0.f, 0.f, 0.f};
        cur = nxt; cA = nA; cB = nB; ++ui;
        if constexpr (ALIGN_EPI) { if (wr == 1) PG8_BAR; }
    }
    PG8_WAIT_V(0);
    if constexpr (!ALIGN_EPI) { if (wr == 0) PG8_BAR; }
    PG8_BAR;
#undef PG8_SA
#undef PG8_SB
#undef PG8_STAGE
#undef PG8_LDA
#undef PG8_LDB
#undef PG8_MMA
#undef PG8_WAIT_V
#undef PG8_WAIT_L
#undef PG8_BAR
#undef PG8_SCHED
}
}


#define XB_TMO      128
#define XB_XCNT(j)  (256  + 64 * (j))
#define XB_XSUB(j)  (1280 + 64 * (j))
#define XB_XGEN(j)  (2304 + 64 * (j))
#define XB_TOP      3328
#define XB_TOPGEN   3392
#define XCD_BAR_WORDS 3456
#define XB_SPIN_CAP (1u << 18)
__device__ __forceinline__ unsigned xb_ld(unsigned* p)              { return __hip_atomic_load(p, __ATOMIC_RELAXED, __HIP_MEMORY_SCOPE_AGENT); }
__device__ __forceinline__ unsigned xb_add(unsigned* p, unsigned v) { return __hip_atomic_fetch_add(p, v, __ATOMIC_RELAXED, __HIP_MEMORY_SCOPE_AGENT); }
__device__ __forceinline__ unsigned xb_xcc_id() { return (unsigned)__builtin_amdgcn_s_getreg((3 << 11) | 20) & 0xFu; }
#define XB_SPIN(cond, bar) do { unsigned _sp = 0; while (cond) { __builtin_amdgcn_s_sleep(1); \
    if ((++_sp & 255u) == 0u) { if (xb_ld(&(bar)[XB_TMO])) break; if (_sp > XB_SPIN_CAP) { atomicAdd(&(bar)[XB_TMO], 1u); break; } } } } while (0)
__device__ __forceinline__ void xcd_barrier_complete(unsigned* bar, unsigned x, unsigned& nloc, unsigned& nx) {
    const unsigned G = gridDim.x * gridDim.y * gridDim.z;
    unsigned sum, cnt, mine, sp = 0u;
    for (;;) {
        sum = 0u; cnt = 0u; mine = 0u;
#pragma unroll
        for (unsigned j = 0; j < 16; ++j) { const unsigned c = xb_ld(&bar[XB_XCNT(j)]); sum += c; cnt += (c > 0u) ? 1u : 0u; mine = (j == x) ? c : mine; }
        if (sum == G) break;
        __builtin_amdgcn_s_sleep(1);
        if ((++sp & 255u) == 0u) { if (xb_ld(&bar[XB_TMO])) break; if (sp > XB_SPIN_CAP) { atomicAdd(&bar[XB_TMO], 1u); break; } }
    }
    nloc = mine > 0u ? mine : 1u; nx = cnt > 0u ? cnt : 1u;
}
__device__ __forceinline__ void xcd_barrier(unsigned* bar, volatile LAS unsigned* st, bool allow_local) {
    asm volatile("s_waitcnt vmcnt(0)" ::: "memory");
    __syncthreads();
    if (threadIdx.x == 0) {
        const unsigned x = xb_xcc_id();
        __builtin_amdgcn_s_waitcnt(0);
        unsigned nloc = st[0], nx = st[1];
        if (nloc == 0u) { xcd_barrier_complete(bar, x, nloc, nx); st[0] = nloc; st[1] = nx; }
        const bool local = allow_local && st[2] != 0u;
        const unsigned old = xb_add(&bar[XB_XSUB(x)], 1u);
        const unsigned gen = old / nloc;
        if (old + 1u == (gen + 1u) * nloc) {
            __builtin_amdgcn_fence(__ATOMIC_RELEASE, "agent");
            asm volatile("s_waitcnt vmcnt(0)" ::: "memory");
            if (!local) {
                const unsigned og = xb_add(&bar[XB_TOP], 1u);
                const unsigned tg = og / nx;
                if (og + 1u == (tg + 1u) * nx) xb_add(&bar[XB_TOPGEN], 1u);
                else XB_SPIN(xb_ld(&bar[XB_TOPGEN]) == tg, bar);
            }
            __builtin_amdgcn_fence(__ATOMIC_ACQUIRE, "agent");
            xb_add(&bar[XB_XGEN(x)], 1u);
            asm volatile("s_waitcnt vmcnt(0)" ::: "memory");
        } else {
            XB_SPIN(xb_ld(&bar[XB_XGEN(x)]) == gen, bar);
            __builtin_amdgcn_fence(__ATOMIC_ACQUIRE, "agent");
            asm volatile("s_waitcnt vmcnt(0)" ::: "memory");
        }
    }
    __syncthreads();
}
struct WMap { int local, grp, rank; };
__device__ __forceinline__ WMap ldmap(LAS unsigned char* lds) {
    volatile LAS unsigned* st = (volatile LAS unsigned*)(lds + 131072 + 64); WMap m;
    m.local = __builtin_amdgcn_readfirstlane((int)st[2]); m.grp = __builtin_amdgcn_readfirstlane((int)st[3]); m.rank = __builtin_amdgcn_readfirstlane((int)st[4]); return m;
}

struct Params {
    const float* x; const float* c; const int* pos; const float* ada_w; const float* ada_b; const float* norm_mix_g; const float* norm_mlp_g;
    const float* pool_w; const float* pool_scale; const float* sgu_w_in; const float* sgu_ln_g; const float* sgu_ln_b; const float* sgu_w_s; const float* sgu_b_s; const float* sgu_w_out;
    const float* mla_w_dq_dkv; const float* mla_q_norm_g; const float* mla_kv_norm_g; const float* mla_w_uq; const float* mla_w_ukv; const float* mla_w_o;
    const float* mlp_w1; const float* mlp_w2; const float* final_g;
    float* out; unsigned char* ws;
};

__device__ __forceinline__ const void* ldarg(int byte_off) {
    const void* r; auto kp = __builtin_amdgcn_kernarg_segment_ptr();
    asm volatile("s_load_dwordx2 %0, %1, %2\n\ts_waitcnt lgkmcnt(0)" : "=s"(r) : "s"(kp), "i"(byte_off) : "memory");
    return r;
}
#define PA(field) ((decltype(Params::field))ldarg((int)offsetof(Params, field)))
__device__ __forceinline__ void p0_transpose_item(const float* W, int K, int N, bf16_t* WT, int row_off, LAS float* scr, int item, int lane) {
    const int nblk = N / 32, kb = item / nblk, nb = item % nblk, k0 = 64 * kb, n0 = 32 * nb;
    float tv[32];
#pragma unroll
    for (int i = 0; i < 32; ++i) { const int kk = 2 * i + (lane >> 5); tv[i] = W[(size_t)(k0 + kk) * N + n0 + (lane & 31)]; }
#pragma unroll
    for (int i = 0; i < 32; ++i) { const int kk = 2 * i + (lane >> 5); scr[kk * 33 + (lane & 31)] = tv[i]; }
    asm volatile("s_waitcnt lgkmcnt(0)" ::: "memory");
    const int c = lane & 7;
#pragma unroll
    for (int j = 0; j < 4; ++j) { const int n = (lane >> 3) + 8 * j; const LAS float* s = scr + (8 * c) * 33 + n;
        u32x4 o; o.x = cvt_pk_bf16(s[0 * 33], s[1 * 33]); o.y = cvt_pk_bf16(s[2 * 33], s[3 * 33]); o.z = cvt_pk_bf16(s[4 * 33], s[5 * 33]); o.w = cvt_pk_bf16(s[6 * 33], s[7 * 33]);
        *(u32x4*)(WT + (size_t)(row_off + n0 + n) * K + k0 + 8 * c) = o; }
    asm volatile("s_waitcnt lgkmcnt(0)" ::: "memory");
}

__device__ __forceinline__ void rope_cs(int pos, int j, float& co, float& si) {
    double inv = 1.0; const double base = 0.74989420933245582730;
    for (int i = 0; i < j; ++i) inv *= base;
    const double ang = (double)pos * inv;
    const double q = rint(ang * 0.63661977236758134308);
    double r = fma(-q, 1.5707963267948966192, ang); r = fma(-q, 6.123233995736766e-17, r);
    const int qi = (int)((long long)q & 3);
    const double r2 = r * r;
    const double sn = r * (1.0 + r2 * (-1.0 / 6 + r2 * (1.0 / 120 + r2 * (-1.0 / 5040 + r2 * (1.0 / 362880 + r2 * (-1.0 / 39916800))))));
    const double cn = 1.0 + r2 * (-0.5 + r2 * (1.0 / 24 + r2 * (-1.0 / 720 + r2 * (1.0 / 40320 + r2 * (-1.0 / 3628800 + r2 * (1.0 / 479001600))))));
    double c, s;
    if (qi == 0) { c = cn; s = sn; } else if (qi == 1) { c = -sn; s = cn; } else if (qi == 2) { c = -cn; s = -sn; } else { c = sn; s = -cn; }
    co = (float)c; si = (float)s;
}

__device__ __forceinline__ void prologue(LAS unsigned char* lds, int G) {
    const int tid = fresh_tid(), lane = tid & 63, wave = __builtin_amdgcn_readfirstlane(tid >> 6), bx = fresh_s(blockIdx.x); G = fresh_s(G);
    unsigned char* ws = PA(ws);
    {
        LAS float* cact = (LAS float*)lds;
        LAS float* red = (LAS float*)(lds + 32768);
        for (int i = tid; i < BATCH * DM; i += NTHREADS) { const float v = PA(c)[i]; cact[i] = v / (1.0f + __expf(-v)); }
        __syncthreads();
        float* mod = (float*)(ws + OFF_MOD);
        for (int item = bx; item < DEPTH * (MODW / 32); item += G) {
            const int li = item / (MODW / 32), n0 = (item % (MODW / 32)) * 32, col = tid & 31, kp = tid >> 5;
            const float* W = PA(ada_w) + (size_t)li * DM * MODW + n0 + col;
            float a[8];
#pragma unroll
            for (int b = 0; b < 8; ++b) a[b] = 0.f;
#pragma unroll 16
            for (int kk = 0; kk < 64; ++kk) { const int k = kp * 64 + kk; const float w = W[(size_t)k * MODW];
#pragma unroll
                for (int b = 0; b < 8; ++b) a[b] += cact[b * DM + k] * w; }
#pragma unroll
            for (int b = 0; b < 8; ++b) red[(kp * 8 + b) * 32 + col] = a[b];
            __syncthreads();
            if (tid < 256) { const int b = tid >> 5; float s = PA(ada_b)[(size_t)li * MODW + n0 + col];
#pragma unroll
                for (int k2 = 0; k2 < 16; ++k2) s += red[(k2 * 8 + b) * 32 + col];
                mod[((size_t)li * 8 + b) * MODW + n0 + col] = s; }
            __syncthreads();
        }
    }
    {
        LAS float* T = (LAS float*)lds;
        bf16_t* QA = (bf16_t*)(ws + OFF_QABS); bf16_t* OA = (bf16_t*)(ws + OFF_OABS);
        for (int item = bx; item < 256; item += G) {
            const int which = item >> 7, h = (item >> 3) & 15, lb = item & 7;
            __syncthreads();
            { const int idx = tid * 4, ll = idx >> 7, d = idx & 127;
              const f32x4 v = *(const f32x4*)(PA(mla_w_ukv) + (size_t)(lb * 16 + ll) * 4096 + h * 256 + which * 128 + d);
              *(LAS f32x4*)(T + ll * 128 + d) = v; }
            __syncthreads();
            if (which == 0) {
                const int i = tid & 255, half = tid >> 8;
                float a[8];
#pragma unroll
                for (int l = 0; l < 8; ++l) a[l] = 0.f;
                const float* qrow = PA(mla_w_uq) + (size_t)i * 3072 + h * 192;
                for (int d4 = 0; d4 < 32; ++d4) { const f32x4 q4 = *(const f32x4*)(qrow + d4 * 4);
#pragma unroll
                    for (int l = 0; l < 8; ++l) { const f32x4 t4 = *(const LAS f32x4*)(T + (half * 8 + l) * 128 + d4 * 4); a[l] += q4[0] * t4[0] + q4[1] * t4[1] + q4[2] * t4[2] + q4[3] * t4[3]; } }
#pragma unroll
                for (int l = 0; l < 8; ++l) { const unsigned pk = cvt_pk_bf16(a[l], 0.f); QA[(size_t)(h * 192 + lb * 16 + half * 8 + l) * 256 + i] = (bf16_t)(pk & 0xffffu); }
            } else {
                float a0[16], a1[16];
#pragma unroll
                for (int l = 0; l < 16; ++l) { a0[l] = 0.f; a1[l] = 0.f; }
                const float* wo = PA(mla_w_o) + (size_t)(h * 128) * 1024 + 2 * tid;
                for (int dv4 = 0; dv4 < 32; ++dv4) {
                    f32x2 w[4];
#pragma unroll
                    for (int e = 0; e < 4; ++e) w[e] = *(const f32x2*)(wo + (size_t)(dv4 * 4 + e) * 1024);
#pragma unroll
                    for (int l = 0; l < 16; ++l) { const f32x4 t4 = *(const LAS f32x4*)(T + l * 128 + dv4 * 4);
#pragma unroll
                        for (int e = 0; e < 4; ++e) { a0[l] += t4[e] * w[e].x; a1[l] += t4[e] * w[e].y; } } }
#pragma unroll
                for (int nn = 0; nn < 2; ++nn) { bf16_t* dst = OA + (size_t)(2 * tid + nn) * 2048 + h * 128 + lb * 16;
                    u32x4 o0, o1;
                    if (nn == 0) { o0.x = cvt_pk_bf16(a0[0], a0[1]); o0.y = cvt_pk_bf16(a0[2], a0[3]); o0.z = cvt_pk_bf16(a0[4], a0[5]); o0.w = cvt_pk_bf16(a0[6], a0[7]);
                                   o1.x = cvt_pk_bf16(a0[8], a0[9]); o1.y = cvt_pk_bf16(a0[10], a0[11]); o1.z = cvt_pk_bf16(a0[12], a0[13]); o1.w = cvt_pk_bf16(a0[14], a0[15]); }
                    else         { o0.x = cvt_pk_bf16(a1[0], a1[1]); o0.y = cvt_pk_bf16(a1[2], a1[3]); o0.z = cvt_pk_bf16(a1[4], a1[5]); o0.w = cvt_pk_bf16(a1[6], a1[7]);
                                   o1.x = cvt_pk_bf16(a1[8], a1[9]); o1.y = cvt_pk_bf16(a1[10], a1[11]); o1.z = cvt_pk_bf16(a1[12], a1[13]); o1.w = cvt_pk_bf16(a1[14], a1[15]); }
                    *(u32x4*)dst = o0; *(u32x4*)(dst + 8) = o1; }
            }
        }
        __syncthreads();
    }
    {
        const int gt = bx * NTHREADS + tid, NGT = G * NTHREADS;
        bf16_t* QA = (bf16_t*)(ws + OFF_QABS);
        for (int idx = gt; idx < 16 * 64 * 256; idx += NGT) {
            const int i = idx & 255, e = (idx >> 8) & 63, h = idx >> 14, j = e >> 1, pp = e & 1;
            const float v = PA(mla_w_uq)[(size_t)i * 3072 + h * 192 + 128 + j + 32 * pp];
            QA[(size_t)(h * 192 + 128 + e) * 256 + i] = (bf16_t)(cvt_pk_bf16(v, 0.f) & 0xffffu);
        }
        bf16_t* WSB = (bf16_t*)(ws + OFF_WSB);
        for (int idx = gt; idx < 8 * 128 * 128; idx += NGT) { const int s = idx & 127, t = (idx >> 7) & 127; const float v = (s <= t) ? PA(sgu_w_s)[idx] : 0.f; WSB[idx] = (bf16_t)(cvt_pk_bf16(v, 0.f) & 0xffffu); }
        unsigned* LZ = (unsigned*)(ws + OFF_LATT + (size_t)448 * 1024 * 2);
        for (int idx = gt; idx < 64 * 1024 / 2; idx += NGT) LZ[idx] = 0u;
        float* cs = (float*)(ws + OFF_CS);
        for (int idx = gt; idx < M * 32; idx += NGT) { const int m = idx >> 5, j = idx & 31; float co, si; rope_cs(PA(pos)[m], j, co, si); cs[(size_t)m * 64 + j] = co; cs[(size_t)m * 64 + 32 + j] = si; }
    }
    {
        LAS float* scr = (LAS float*)(lds + wave * 16384);
        const int gw = bx * NWAVES + wave, NGW = G * NWAVES;
        constexpr int I_POOL = 8 * 4 * 8, I_IN = 16 * 64, I_OUT = 16 * 32, I_LAT = 16 * 14, I_W1 = 16 * 128, I_W2 = 64 * 32;
        constexpr int NITEMS = I_POOL + I_IN + I_OUT + I_LAT + 4 * I_W1 + 4 * I_W2;
        for (int it = gw; it < NITEMS; it += NGW) {
            int r = it;
            if (r < I_POOL) { const int mat = r >> 5, l = mat >> 2, gq = mat & 3; p0_transpose_item(PA(pool_w) + (size_t)mat * 65536, 256, 256, (bf16_t*)(ws + OFF_POOLT) + (size_t)l * 1024 * 256, gq * 256, scr, r & 31, lane); continue; } r -= I_POOL;
            if (r < I_IN) { p0_transpose_item(PA(sgu_w_in), 1024, 2048, (bf16_t*)(ws + OFF_SGUIN), 0, scr, r, lane); continue; } r -= I_IN;
            if (r < I_OUT) { p0_transpose_item(PA(sgu_w_out), 1024, 1024, (bf16_t*)(ws + OFF_SGUOUT), 0, scr, r, lane); continue; } r -= I_OUT;
            if (r < I_LAT) { p0_transpose_item(PA(mla_w_dq_dkv), 1024, 448, (bf16_t*)(ws + OFF_LATT), 0, scr, r, lane); continue; } r -= I_LAT;
            if (r < 4 * I_W1) { const int li = r / I_W1; p0_transpose_item(PA(mlp_w1) + (size_t)li * DM * FF, DM, FF, (bf16_t*)(ws + OFF_W1T) + (size_t)li * DM * FF, 0, scr, r % I_W1, lane); continue; } r -= 4 * I_W1;
            { const int li = r / I_W2; p0_transpose_item(PA(mlp_w2) + (size_t)li * DM * FF, FF, DM, (bf16_t*)(ws + OFF_W2T) + (size_t)li * DM * FF, 0, scr, r % I_W2, lane); }
        }
    }
}

template <bool XF32> __device__ __forceinline__ void norm_mod_phase(const void* __restrict__ xin, bf16_t* __restrict__ H, const float* g, const float* shift, const float* scale, int G, WMap mp) {
    const int tid = fresh_tid(), lane = tid & 63, wave = __builtin_amdgcn_readfirstlane(tid >> 6); const int gw = fresh_s(blockIdx.x) * NWAVES + wave, NGW = fresh_s(G) * NWAVES;
    const int it0 = mp.local ? mp.grp * 1024 + mp.rank * 8 + wave : gw, itstep = mp.local ? 256 : NGW, itend = mp.local ? (mp.grp + 1) * 1024 : M / 4;
    for (int it = it0; it < itend; it += itstep) {
        const int m0 = it * 4, b = m0 >> 12;
        f32x4 v[4][4]; float s[4];
#pragma unroll
        for (int r = 0; r < 4; ++r) {
#pragma unroll
            for (int j = 0; j < 4; ++j) v[r][j] = ldx4<XF32>(xin, (size_t)(m0 + r) * (DM / 4) + lane + 64 * j); }
#pragma unroll
        for (int r = 0; r < 4; ++r) { float t = 0.f;
#pragma unroll
            for (int j = 0; j < 4; ++j) t += (v[r][j][0] * v[r][j][0] + v[r][j][1] * v[r][j][1]) + (v[r][j][2] * v[r][j][2] + v[r][j][3] * v[r][j][3]);
            s[r] = t; }
#pragma unroll
        for (int o = 1; o < 64; o <<= 1) {
#pragma unroll
            for (int r = 0; r < 4; ++r) s[r] += shfl_x(s[r], lane, o); }
        float rstd[4];
#pragma unroll
        for (int r = 0; r < 4; ++r) rstd[r] = rsqrtf(s[r] * (1.f / DM) + RMS_EPS);
#pragma unroll
        for (int j = 0; j < 4; ++j) { const int col = 4 * lane + 256 * j;
            const f32x4 gg = *(const f32x4*)(g + col), sc = *(const f32x4*)(scale + (size_t)b * MODW + col), sh = *(const f32x4*)(shift + (size_t)b * MODW + col);
            const f32x4 gm = gg * (sc + 1.0f);
#pragma unroll
            for (int r = 0; r < 4; ++r) { const f32x4 y = v[r][j] * rstd[r] * gm + sh;
                u32x2 w; w.x = cvt_pk_bf16(y[0], y[1]); w.y = cvt_pk_bf16(y[2], y[3]); *((u32x2*)(H + (size_t)(m0 + r) * DM) + lane + 64 * j) = w; } }
    }
}
__device__ __forceinline__ void final_norm_phase(const bf16_t* __restrict__ xb, float* __restrict__ xo, const float* g, int G, WMap mp) {
    const int tid = fresh_tid(), lane = tid & 63, wave = __builtin_amdgcn_readfirstlane(tid >> 6); const int gw = fresh_s(blockIdx.x) * NWAVES + wave, NGW = fresh_s(G) * NWAVES;
    const int it0 = mp.local ? mp.grp * 1024 + mp.rank * 8 + wave : gw, itstep = mp.local ? 256 : NGW, itend = mp.local ? (mp.grp + 1) * 1024 : M / 4;
    for (int it = it0; it < itend; it += itstep) {
        const int m0 = it * 4;
        f32x4 v[4][4]; float s[4];
#pragma unroll
        for (int r = 0; r < 4; ++r) {
#pragma unroll
            for (int j = 0; j < 4; ++j) v[r][j] = ldx4<false>(xb, (size_t)(m0 + r) * (DM / 4) + lane + 64 * j); }
#pragma unroll
        for (int r = 0; r < 4; ++r) { float t = 0.f;
#pragma unroll
            for (int j = 0; j < 4; ++j) t += (v[r][j][0] * v[r][j][0] + v[r][j][1] * v[r][j][1]) + (v[r][j][2] * v[r][j][2] + v[r][j][3] * v[r][j][3]);
            s[r] = t; }
#pragma unroll
        for (int o = 1; o < 64; o <<= 1) {
#pragma unroll
            for (int r = 0; r < 4; ++r) s[r] += shfl_x(s[r], lane, o); }
#pragma unroll
        for (int j = 0; j < 4; ++j) { const f32x4 gg = *(const f32x4*)(g + 4 * lane + 256 * j);
#pragma unroll
            for (int r = 0; r < 4; ++r) { const float rstd = rsqrtf(s[r] * (1.f / DM) + RMS_EPS); *((f32x4*)(xo + (size_t)(m0 + r) * DM) + lane + 64 * j) = v[r][j] * rstd * gg; } }
    }
}

template <int W, bool XF32> __device__ __forceinline__ void pool_cols(const void* __restrict__ xin, bf16_t* __restrict__ out, bf16_t* __restrict__ xcopy, long row0, bool has_halo, const LAS float* rs, f32x2 Gm, f32x2 SH, int tid) {
    float r0[16], r1[16];
#pragma unroll
    for (int k = 0; k < 16; ++k) { r0[k] = 0.f; r1[k] = 0.f; }
    const int rlo = has_halo ? 0 : 15; const size_t xi2 = (size_t)(row0 - 15) * (DM / 2) + tid;
    for (int c = 0; c < 5; ++c) {
        f32x2 xv[16];
#pragma unroll
        for (int k = 0; k < 16; ++k) { int r = c * 16 + k; r = r < rlo ? rlo : (r > 78 ? 78 : r);
            xv[k] = ldx2<XF32>(xin, xi2 + (size_t)r * (DM / 2)); }
#pragma unroll
        for (int k = 0; k < 16; ++k) {
            const int r = c * 16 + k;
            if (r < 79) {
                float h0 = 0.f, h1 = 0.f;
                if (has_halo || r >= 15) { const float rr = rs[r]; h0 = xv[k].x * rr * Gm.x + SH.x; h1 = xv[k].y * rr * Gm.y + SH.y; }
                r0[k] = h0; r1[k] = h1;
                if (r >= 15) {
                    if (XF32) *(unsigned*)(xcopy + (size_t)(row0 + r - 15) * DM + 2 * tid) = cvt_pk_bf16(xv[k].x, xv[k].y);
                    float s0 = 0.f, s1 = 0.f;
#pragma unroll
                    for (int i = 0; i < W; ++i) { s0 += r0[(k - i) & 15]; s1 += r1[(k - i) & 15]; }
                    const int tb = (int)((row0 + r - 15) & (SEQ - 1)); const int cnt = (tb + 1) < W ? (tb + 1) : W; const float ic = 1.0f / (float)cnt;
                    *(unsigned*)(out + (size_t)(row0 + r - 15) * DM + 2 * tid) = cvt_pk_bf16(s0 * ic - h0, s1 * ic - h1);
                }
            }
        }
    }
}
template <bool XF32> __device__ __forceinline__ void pool_pre_phase(LAS unsigned char* lds, const void* __restrict__ xin, bf16_t* __restrict__ H, bf16_t* __restrict__ xcopy, const float* g, const float* shift, const float* scale, int G, WMap mp) {
    const int tid = fresh_tid(), lane = tid & 63, wave = __builtin_amdgcn_readfirstlane(tid >> 6);
    LAS float* rs = (LAS float*)lds;
    G = fresh_s(G);
    const int it0 = mp.local ? mp.grp * 64 + mp.rank : fresh_s(blockIdx.x), itstep = mp.local ? 32 : G, itend = mp.local ? (mp.grp + 1) * 64 : M / 64;
    for (int item = it0; item < itend; item += itstep) {
        const long row0 = (long)item * 64; const bool has_halo = (row0 & (SEQ - 1)) != 0; const int b = (int)(row0 >> 12);
        __syncthreads();
        const int rlo = has_halo ? 0 : 15;
        for (int half = 0; half < 2; ++half) {
            f32x4 v[5][4];
#pragma unroll
            for (int i = 0; i < 5; ++i) { int r = wave * 10 + half * 5 + i; r = r < rlo ? rlo : (r > 78 ? 78 : r);
#pragma unroll
                for (int j = 0; j < 4; ++j) v[i][j] = ldx4<XF32>(xin, (size_t)(row0 - 15 + r) * (DM / 4) + lane + 64 * j); }
#pragma unroll
            for (int i = 0; i < 5; ++i) { const int r = wave * 10 + half * 5 + i; float s = 0.f;
#pragma unroll
                for (int j = 0; j < 4; ++j) s += (v[i][j][0] * v[i][j][0] + v[i][j][1] * v[i][j][1]) + (v[i][j][2] * v[i][j][2] + v[i][j][3] * v[i][j][3]);
                const float rstd = rsqrtf(wave_sum(s, lane) * (1.f / DM) + RMS_EPS);
                if (lane == 0 && r < 79) rs[r] = rstd; }
        }
        __syncthreads();
        const int col = 2 * tid;
        const f32x2 gg = *(const f32x2*)(g + col), sc = *(const f32x2*)(scale + (size_t)b * MODW + col), sh = *(const f32x2*)(shift + (size_t)b * MODW + col);
        const f32x2 Gm = gg * (sc + 1.0f);
        const int grp = wave >> 1;
        if (grp == 0) pool_cols<2, XF32>(xin, H, xcopy, row0, has_halo, rs, Gm, sh, tid);
        else if (grp == 1) pool_cols<4, XF32>(xin, H, xcopy, row0, has_halo, rs, Gm, sh, tid);
        else if (grp == 2) pool_cols<8, XF32>(xin, H, xcopy, row0, has_halo, rs, Gm, sh, tid);
        else pool_cols<16, XF32>(xin, H, xcopy, row0, has_halo, rs, Gm, sh, tid);
    }
    __syncthreads();
}

__device__ __forceinline__ void sgu_spatial_phase(LAS unsigned char* lds, const bf16_t* Z, const bf16_t* WSB, const float* ln_g, const float* ln_b, const float* b_s, bf16_t* GT, int G, WMap mp) {
    const int tid = fresh_tid(), lane = tid & 63, wave = __builtin_amdgcn_readfirstlane(tid >> 6);
    LAS float* st = (LAS float*)lds;
    LAS bf16_t* VT = (LAS bf16_t*)(lds + 1024);
    constexpr int VP = 136;
    G = fresh_s(G);
    const int it0 = mp.local ? mp.grp * 32 + mp.rank : fresh_s(blockIdx.x), itstep = mp.local ? 32 : G, itend = mp.local ? (mp.grp + 1) * 32 : M / 128;
    for (int item = it0; item < itend; item += itstep) {
        const size_t tok0 = (size_t)item * 128;
        __syncthreads();
        for (int rr = 0; rr < 16; ++rr) { const int row = wave * 16 + rr; const bf16_t* vp = Z + (tok0 + row) * 2048 + 1024 + 8 * lane;
            const u32x4 a = *(const u32x4*)vp, bq = *(const u32x4*)(vp + 512);
            float f[16]; f[0] = bflo(a.x); f[1] = bfhi(a.x); f[2] = bflo(a.y); f[3] = bfhi(a.y); f[4] = bflo(a.z); f[5] = bfhi(a.z); f[6] = bflo(a.w); f[7] = bfhi(a.w);
            f[8] = bflo(bq.x); f[9] = bfhi(bq.x); f[10] = bflo(bq.y); f[11] = bfhi(bq.y); f[12] = bflo(bq.z); f[13] = bfhi(bq.z); f[14] = bflo(bq.w); f[15] = bfhi(bq.w);
            float s = 0.f;
#pragma unroll
            for (int i = 0; i < 16; ++i) s += f[i];
            const float mean = wave_sum(s, lane) * (1.f / 1024); float q = 0.f;
#pragma unroll
            for (int i = 0; i < 16; ++i) { const float d = f[i] - mean; q += d * d; }
            const float rstd = rsqrtf(wave_sum(q, lane) * (1.f / 1024) + LN_EPS);
            if (lane == 0) { st[row * 2] = mean; st[row * 2 + 1] = rstd; } }
        __syncthreads();
        for (int hd = 0; hd < 8; ++hd) {
#pragma unroll
            for (int it = 0; it < 4; ++it) { const int idx = it * NTHREADS + tid, s = idx & 127, c8 = idx >> 7;
                const u32x4 a = *(const u32x4*)(Z + (tok0 + s) * 2048 + 1024 + hd * 128 + c8 * 8);
                const float mean = st[s * 2], rstd = st[s * 2 + 1];
                const f32x4 g0 = *(const f32x4*)(ln_g + hd * 128 + c8 * 8), g1 = *(const f32x4*)(ln_g + hd * 128 + c8 * 8 + 4);
                const f32x4 b0 = *(const f32x4*)(ln_b + hd * 128 + c8 * 8), b1 = *(const f32x4*)(ln_b + hd * 128 + c8 * 8 + 4);
                float y[8];
                y[0] = (bflo(a.x) - mean) * rstd * g0[0] + b0[0]; y[1] = (bfhi(a.x) - mean) * rstd * g0[1] + b0[1];
                y[2] = (bflo(a.y) - mean) * rstd * g0[2] + b0[2]; y[3] = (bfhi(a.y) - mean) * rstd * g0[3] + b0[3];
                y[4] = (bflo(a.z) - mean) * rstd * g1[0] + b1[0]; y[5] = (bfhi(a.z) - mean) * rstd * g1[1] + b1[1];
                y[6] = (bflo(a.w) - mean) * rstd * g1[2] + b1[2]; y[7] = (bfhi(a.w) - mean) * rstd * g1[3] + b1[3];
#pragma unroll
                for (int i = 0; i < 8; i += 2) { const unsigned pk = cvt_pk_bf16(y[i], y[i + 1]); VT[(c8 * 8 + i) * VP + s] = (bf16_t)(pk & 0xffffu); VT[(c8 * 8 + i + 1) * VP + s] = (bf16_t)(pk >> 16); } }
            __syncthreads();
            const int tb = wave & 3, ch = wave >> 2, r32 = lane & 31, hi = lane >> 5;
            f32x16 acc0, acc1;
#pragma unroll
            for (int r = 0; r < 16; ++r) { acc0[r] = 0.f; acc1[r] = 0.f; }
            const bf16_t* wp = WSB + (size_t)hd * 16384 + (tb * 32 + r32) * 128 + 8 * hi;
            const LAS bf16_t* vb = VT + (ch * 64 + r32) * VP + 8 * hi;
            for (int ks = 0; ks < 2 * (tb + 1); ++ks) {
                const bf16x8 a = *(const bf16x8*)(wp + ks * 16);
                const bf16x8 b0 = *(const LAS bf16x8*)(vb + ks * 16), b1 = *(const LAS bf16x8*)(vb + 32 * VP + ks * 16);
                acc0 = __builtin_amdgcn_mfma_f32_32x32x16_bf16(a, b0, acc0, 0, 0, 0);
                acc1 = __builtin_amdgcn_mfma_f32_32x32x16_bf16(a, b1, acc1, 0, 0, 0);
            }
#pragma unroll
            for (int r = 0; r < 16; ++r) { const int t = tb * 32 + (r & 3) + 8 * (r >> 2) + 4 * hi; const float bias = b_s[hd * 128 + t];
                const int c = hd * 128 + ch * 64 + r32;
                const float u0 = bf2f(Z[(tok0 + t) * 2048 + c]), u1 = bf2f(Z[(tok0 + t) * 2048 + c + 32]);
                GT[(tok0 + t) * 1024 + c] = (bf16_t)(cvt_pk_bf16(u0 * (acc0[r] + bias), 0.f) & 0xffffu);
                GT[(tok0 + t) * 1024 + c + 32] = (bf16_t)(cvt_pk_bf16(u1 * (acc1[r] + bias), 0.f) & 0xffffu); }
            __syncthreads();
        }
    }
}

__device__ __forceinline__ void lat_norm_phase(const bf16_t* LAT, const float* cs, const float* qg, const float* kvg, bf16_t* CQ, bf16_t* KK, bf16_t* VT, int G, WMap mp) {
    const int tid = fresh_tid(), lane = tid & 63, wave = __builtin_amdgcn_readfirstlane(tid >> 6); const int gw = fresh_s(blockIdx.x) * NWAVES + wave, NGW = fresh_s(G) * NWAVES;
    const f32x4 qg4 = *(const f32x4*)(qg + 4 * lane); const f32x2 kg2 = *(const f32x2*)(kvg + 2 * lane);
    const int it0 = mp.local ? mp.grp * 512 + mp.rank * 8 + wave : gw, itstep = mp.local ? 256 : NGW, itend = mp.local ? (mp.grp + 1) * 512 : M / 8;
    for (int item = it0; item < itend; item += itstep) {
        const int t0 = item * 8, b = t0 >> 12;
        float k0[8], k1[8];
#pragma unroll
        for (int tt = 0; tt < 8; ++tt) { const size_t row = (size_t)t0 + tt; const bf16_t* lp = LAT + row * QPITCH;
            const u32x2 qraw = *(const u32x2*)(lp + 4 * lane); const unsigned kvraw = *(const unsigned*)(lp + 256 + 2 * lane);
            const f32x4 q4 = (f32x4){bflo(qraw.x), bfhi(qraw.x), bflo(qraw.y), bfhi(qraw.y)}; const f32x2 kv2 = (f32x2){bflo(kvraw), bfhi(kvraw)}; const float kr = bf2f(lp[384 + lane]);
            const float rq = rsqrtf(wave_sum((q4[0] * q4[0] + q4[1] * q4[1]) + (q4[2] * q4[2] + q4[3] * q4[3]), lane) * (1.f / 256) + RMS_EPS);
            const float rkv = rsqrtf(wave_sum(kv2.x * kv2.x + kv2.y * kv2.y, lane) * (1.f / 128) + RMS_EPS);
            const f32x4 cq = q4 * rq * qg4; u32x2 w; w.x = cvt_pk_bf16(cq[0], cq[1]); w.y = cvt_pk_bf16(cq[2], cq[3]); *(u32x2*)(CQ + row * 256 + 4 * lane) = w;
            const float n0 = kv2.x * rkv * kg2.x, n1 = kv2.y * rkv * kg2.y; const unsigned pk = cvt_pk_bf16(n0, n1); *(unsigned*)(KK + row * 192 + 2 * lane) = pk;
            k0[tt] = bflo(pk); k1[tt] = bfhi(pk);
            const float partner = shfl_x(kr, lane, 32); const int j = lane & 31; const float co = cs[row * 64 + j], si = cs[row * 64 + 32 + j];
            const float val = (lane < 32) ? (kr * co - partner * si) : (kr * co + partner * si);
            KK[row * 192 + 128 + 2 * j + (lane >> 5)] = (bf16_t)(cvt_pk_bf16(val, 0.f) & 0xffffu); }
        u32x4 o0, o1;
        o0.x = cvt_pk_bf16(k0[0], k0[1]); o0.y = cvt_pk_bf16(k0[2], k0[3]); o0.z = cvt_pk_bf16(k0[4], k0[5]); o0.w = cvt_pk_bf16(k0[6], k0[7]);
        o1.x = cvt_pk_bf16(k1[0], k1[1]); o1.y = cvt_pk_bf16(k1[2], k1[3]); o1.z = cvt_pk_bf16(k1[4], k1[5]); o1.w = cvt_pk_bf16(k1[6], k1[7]);
        *(u32x4*)(VT + ((size_t)b * 128 + 2 * lane) * SEQ + (t0 & (SEQ - 1))) = o0;
        *(u32x4*)(VT + ((size_t)b * 128 + 2 * lane + 1) * SEQ + (t0 & (SEQ - 1))) = o1;
    }
}

__device__ __forceinline__ void attn_phase(LAS unsigned char* lds, const bf16_t* Q, const bf16_t* KK, const bf16_t* VT, bf16_t* OL, int vcu, int G) {
    const int tid = fresh_tid(), lane = tid & 63, wave = __builtin_amdgcn_readfirstlane(tid >> 6), q = lane & 31, hi = lane >> 5;
    constexpr int KPB = 400, VPB = 136  , KBYTES = 64 * KPB, VBYTES = 128 * VPB, BUF = KBYTES + VBYTES;
    constexpr float ATT_THR = 8.0f;
    G = fresh_s(G); vcu = fresh_s(vcu);
    for (int U = vcu; U < 2048; U += G) {
        const int v = U & 255, iu = U >> 8; const int combo = v >> 4, s = v & 15, b = combo >> 1, hg = combo & 1;
        const int k2 = iu >> 1; const int qb = (iu & 1) ? (32 * k2 + 31 - s) : (32 * k2 + s);
        const int h = hg * 8 + wave; const int NT = (qb >> 1) + 1;
        const size_t rowbase = (size_t)b * SEQ + (size_t)qb * 32;
        bf16x8 qf[12];
        { const bf16_t* qp = Q + (rowbase + q) * QPITCH + h * 192 + hi * 8;
#pragma unroll
          for (int ds = 0; ds < 12; ++ds) qf[ds] = *(const bf16x8*)(qp + ds * 16); }
        f32x16 o[4];
#pragma unroll
        for (int d = 0; d < 4; ++d)
#pragma unroll
            for (int r = 0; r < 16; ++r) o[d][r] = 0.f;
        float mref = 0.f, lrun = 0.f;
        const bf16_t* Kb = KK + (size_t)b * SEQ * 192; const bf16_t* Vb = VT + (size_t)b * 128 * SEQ;
        u32x4 kr[3], vr[2];
#define ATT_LOAD(t) do { _Pragma("unroll") for (int it = 0; it < 3; ++it) kr[it] = *(const u32x4*)(Kb + (size_t)(t) * 64 * 192 + (size_t)(tid + 512 * it) * 8); \
                         _Pragma("unroll") for (int it = 0; it < 2; ++it) { const int idx = tid + 512 * it; vr[it] = *(const u32x4*)(Vb + (size_t)(idx >> 3) * SEQ + (t) * 64 + (idx & 7) * 8); } } while (0)
#define ATT_STORE(buf) do { _Pragma("unroll") for (int it = 0; it < 3; ++it) { const int idx = tid + 512 * it; *(LAS u32x4*)(lds + (buf) * BUF + (idx / 24) * KPB + (idx % 24) * 16) = kr[it]; } \
                            _Pragma("unroll") for (int it = 0; it < 2; ++it) { const int idx = tid + 512 * it; LAS unsigned char* vd = lds + (buf) * BUF + KBYTES + (idx >> 3) * VPB + (idx & 7) * 16; \
                                *(LAS u32x2*)vd = (u32x2){vr[it].x, vr[it].y}; *(LAS u32x2*)(vd + 8) = (u32x2){vr[it].z, vr[it].w}; } } while (0)
        ATT_LOAD(0); ATT_STORE(0); __syncthreads();
        for (int t = 0; t < NT; ++t) {
            if (t + 1 < NT) ATT_LOAD(t + 1);
            const LAS unsigned char* kb = lds + (t & 1) * BUF; const LAS unsigned char* vb = kb + KBYTES;
            f32x16 p0, p1;
            { const float nm = -mref;
#pragma unroll
              for (int r = 0; r < 16; ++r) { p0[r] = nm; p1[r] = nm; } }
            __builtin_amdgcn_s_setprio(1);
#pragma unroll
            for (int ds = 0; ds < 12; ++ds) {
                const bf16x8 a0 = *(const LAS bf16x8*)(kb + q * KPB + ds * 32 + hi * 16), a1 = *(const LAS bf16x8*)(kb + (q + 32) * KPB + ds * 32 + hi * 16);
                p0 = __builtin_amdgcn_mfma_f32_32x32x16_bf16(a0, qf[ds], p0, 0, 0, 0);
                p1 = __builtin_amdgcn_mfma_f32_32x32x16_bf16(a1, qf[ds], p1, 0, 0, 0);
            }
            __builtin_amdgcn_s_setprio(0);
            if (t == NT - 1) { const int qpos = qb * 32 + q, kbase = t * 64 + 4 * hi;
#pragma unroll
                for (int r = 0; r < 16; ++r) { const int key = kbase + (r & 3) + 8 * (r >> 2); if (key > qpos) p0[r] = -INFINITY; if (key + 32 > qpos) p1[r] = -INFINITY; } }
            float mx = fmaxf(p0[0], p1[0]);
#pragma unroll
            for (int r = 1; r < 16; ++r) mx = fmaxf(mx, fmaxf(p0[r], p1[r]));
            if (__builtin_expect(t == 0 || __any(mx > ATT_THR), 0)) {
                const float rm = fmaxf(mx, shfl_x(mx, lane, 32));
                const float dl = (t == 0) ? rm : fmaxf(rm, 0.f);
                mref += dl;
                const float f = __builtin_amdgcn_exp2f(-dl);
                lrun *= f;
#pragma unroll
                for (int r = 0; r < 16; ++r) { p0[r] -= dl; p1[r] -= dl; }
#pragma unroll
                for (int d = 0; d < 4; ++d)
#pragma unroll
                    for (int r = 0; r < 16; ++r) o[d][r] *= f;
            }
            float rsum = 0.f;
#pragma unroll
            for (int r = 0; r < 16; ++r) { p0[r] = __builtin_amdgcn_exp2f(p0[r]); p1[r] = __builtin_amdgcn_exp2f(p1[r]); rsum += p0[r] + p1[r]; }
            lrun += rsum;
            u32x4 w00, w01, w10, w11;
            w00.x = cvtpk_s(p0[0], p0[1]); w00.y = cvtpk_s(p0[2], p0[3]); w00.z = cvtpk_s(p0[4], p0[5]); w00.w = cvtpk_s(p0[6], p0[7]);
            w01.x = cvtpk_s(p0[8], p0[9]); w01.y = cvtpk_s(p0[10], p0[11]); w01.z = cvtpk_s(p0[12], p0[13]); w01.w = cvtpk_s(p0[14], p0[15]);
            w10.x = cvtpk_s(p1[0], p1[1]); w10.y = cvtpk_s(p1[2], p1[3]); w10.z = cvtpk_s(p1[4], p1[5]); w10.w = cvtpk_s(p1[6], p1[7]);
            w11.x = cvtpk_s(p1[8], p1[9]); w11.y = cvtpk_s(p1[10], p1[11]); w11.z = cvtpk_s(p1[12], p1[13]); w11.w = cvtpk_s(p1[14], p1[15]);
            const bf16x8 pa00 = __builtin_bit_cast(bf16x8, w00), pa01 = __builtin_bit_cast(bf16x8, w01), pa10 = __builtin_bit_cast(bf16x8, w10), pa11 = __builtin_bit_cast(bf16x8, w11);
            __builtin_amdgcn_s_setprio(1);
#pragma unroll
            for (int d = 0; d < 4; ++d) {
                const LAS unsigned char* vp = vb + (d * 32 + q) * VPB + hi * 8;
#define ATT_PV(off, PA) do { const u32x2 lo = *(const LAS u32x2*)(vp + (off) * 2), hh = *(const LAS u32x2*)(vp + (off) * 2 + 16); \
                             const u32x4 av = (u32x4){lo.x, lo.y, hh.x, hh.y}; o[d] = __builtin_amdgcn_mfma_f32_32x32x16_bf16(__builtin_bit_cast(bf16x8, av), PA, o[d], 0, 0, 0); } while (0)
                ATT_PV(0, pa00); ATT_PV(16, pa01); ATT_PV(32, pa10); ATT_PV(48, pa11);
#undef ATT_PV
            }
            __builtin_amdgcn_s_setprio(0);
            if (t + 1 < NT) ATT_STORE((t + 1) & 1);
            __syncthreads();
        }
#undef ATT_LOAD
#undef ATT_STORE
        lrun += shfl_x(lrun, lane, 32);
        const float inv = 1.0f / lrun;
        bf16_t* op = OL + (rowbase + q) * 2048 + h * 128 + 8 * hi;
#pragma unroll
        for (int d = 0; d < 4; ++d)
#pragma unroll
            for (int gp = 0; gp < 2; ++gp) {
                const int A = 2 * gp, B = 2 * gp + 1;
                const unsigned ax = cvt_pk_bf16(o[d][4 * A] * inv, o[d][4 * A + 1] * inv), ay = cvt_pk_bf16(o[d][4 * A + 2] * inv, o[d][4 * A + 3] * inv);
                const unsigned bx = cvt_pk_bf16(o[d][4 * B] * inv, o[d][4 * B + 1] * inv), by = cvt_pk_bf16(o[d][4 * B + 2] * inv, o[d][4 * B + 3] * inv);
                const auto sx = __builtin_amdgcn_permlane32_swap(ax, bx, false, false), sy = __builtin_amdgcn_permlane32_swap(ay, by, false, false);
                u32x4 w; w.x = sx[0]; w.y = sy[0]; w.z = sx[1]; w.w = sy[1];
                *(u32x4*)(op + d * 32 + 16 * gp) = w; }
    }
}

#define GEMM_RUN(EPI_T, epi, Aptr, Bptr, N_, K_, lda_, ldb_, astep_) do { const WMap mp_ = ldmap(lds); pg8::Gemm g_{(const bf16_t*)(Aptr), (const bf16_t*)(Bptr)}; \
    pg8::StaticOrder S_; S_.init(M, (N_), fresh_s(G), fresh_s(mp_.local ? mp_.rank * 8 + mp_.grp : ((G == 256) ? (int)((blockIdx.x * 37u) & 255u) : (int)blockIdx.x))); pg8::gemm_phase<EPI_T, true, true, (K_), (lda_), (ldb_), (astep_)>(lds, g_, S_, (epi)); } while (0)

#define WSP(T, off) ((T*)(PA(ws) + (off)))
#define MODL(li, off) (WSP(float, OFF_MOD) + (size_t)(li) * BATCH * MODW + (off))

#define GSYNC_G() xcd_barrier(WSP(unsigned, OFF_BAR), (volatile LAS unsigned*)(lds + 131072 + 64), false)
#define GSYNC_L() xcd_barrier(WSP(unsigned, OFF_BAR), (volatile LAS unsigned*)(lds + 131072 + 64), true)
#define GEMM_RUN_X(EPI_T, epi, Aptr, Bptr, N_, K_, lda_, ldb_, astep_, PMX_) do { const WMap mp_ = ldmap(lds); pg8::Gemm g_{(const bf16_t*)(Aptr), (const bf16_t*)(Bptr)}; \
    pg8::StaticOrder S_; S_.init(M, (N_), fresh_s(G), fresh_s(mp_.local ? mp_.rank * 8 + mp_.grp : ((G == 256) ? (int)((blockIdx.x * 37u) & 255u) : (int)blockIdx.x))); S_.pmx = (PMX_); pg8::gemm_phase<EPI_T, true, true, (K_), (lda_), (ldb_), (astep_)>(lds, g_, S_, (epi)); } while (0)
template <int li> __device__ __forceinline__ void layer_phases(LAS unsigned char* lds, int G) {
        constexpr int kind = li % 3;
        if constexpr (kind == 0) {
            constexpr int j = li / 3;
            pool_pre_phase<li == 0>(lds, (li == 0) ? (const void*)PA(x) : (const void*)WSP(bf16_t, OFF_XB), WSP(bf16_t, OFF_H), WSP(bf16_t, OFF_XB), PA(norm_mix_g) + li * DM, MODL(li, 0), MODL(li, DM), G, ldmap(lds));
            GSYNC_L();
            { pg8::EpiRes<false> e{WSP(bf16_t, OFF_XB), WSP(bf16_t, OFF_XB), MODL(li, 2 * DM), PA(pool_scale) + j * DM};
              GEMM_RUN(pg8::EpiRes<false>, e, WSP(bf16_t, OFF_H), WSP(bf16_t, OFF_POOLT) + (size_t)j * 1024 * 256, DM, 256, DM, 256, 256); }
            GSYNC_L();
        } else if constexpr (kind == 1) {
            norm_mod_phase<false>(WSP(bf16_t, OFF_XB), WSP(bf16_t, OFF_H), PA(norm_mix_g) + li * DM, MODL(li, 0), MODL(li, DM), G, ldmap(lds));
            GSYNC_L();
            { pg8::EpiBf16<1> e{(bf16_t*)PA(out), 2048}; GEMM_RUN(pg8::EpiBf16<1>, e, WSP(bf16_t, OFF_H), WSP(bf16_t, OFF_SGUIN), 2048, DM, DM, DM, 0); }
            GSYNC_L();
            sgu_spatial_phase(lds, (const bf16_t*)PA(out), WSP(bf16_t, OFF_WSB), PA(sgu_ln_g), PA(sgu_ln_b), PA(sgu_b_s), WSP(bf16_t, OFF_H), G, ldmap(lds));
            GSYNC_L();
            { pg8::EpiRes<false> e{WSP(bf16_t, OFF_XB), WSP(bf16_t, OFF_XB), MODL(li, 2 * DM), nullptr}; GEMM_RUN(pg8::EpiRes<false>, e, WSP(bf16_t, OFF_H), WSP(bf16_t, OFF_SGUOUT), DM, DM, DM, DM, 0); }
            GSYNC_L();
        } else {
            norm_mod_phase<false>(WSP(bf16_t, OFF_XB), WSP(bf16_t, OFF_H), PA(norm_mix_g) + li * DM, MODL(li, 0), MODL(li, DM), G, ldmap(lds));
            GSYNC_L();
            { pg8::EpiBf16<0> e{WSP(bf16_t, OFF_LAT), QPITCH}; GEMM_RUN(pg8::EpiBf16<0>, e, WSP(bf16_t, OFF_H), WSP(bf16_t, OFF_LATT), 512, DM, DM, DM, 0); }
            GSYNC_L();
            lat_norm_phase(WSP(bf16_t, OFF_LAT), WSP(float, OFF_CS), PA(mla_q_norm_g), PA(mla_kv_norm_g), WSP(bf16_t, OFF_CQ), WSP(bf16_t, OFF_KK), WSP(bf16_t, OFF_VT), G, ldmap(lds));
            GSYNC_L();
            { pg8::EpiQ e{WSP(bf16_t, OFF_BIG), WSP(float, OFF_CS), 0.07216878364870323f * 1.4426950408889634f}; GEMM_RUN(pg8::EpiQ, e, WSP(bf16_t, OFF_CQ), WSP(bf16_t, OFF_QABS), 3072, 256, 256, 256, 0); }
            GSYNC_L();
            { const WMap mpa = ldmap(lds); const int vcu = mpa.local ? mpa.grp * 32 + mpa.rank : ((G % 8 == 0) ? ((int)blockIdx.x % 8) * (G / 8) + (int)blockIdx.x / 8 : (int)blockIdx.x);
              attn_phase(lds, WSP(bf16_t, OFF_BIG), WSP(bf16_t, OFF_KK), WSP(bf16_t, OFF_VT), (bf16_t*)PA(out), vcu, G); }
            GSYNC_L();
            { pg8::EpiRes<false> e{WSP(bf16_t, OFF_XB), WSP(bf16_t, OFF_XB), MODL(li, 2 * DM), nullptr}; GEMM_RUN(pg8::EpiRes<false>, e, (const bf16_t*)PA(out), WSP(bf16_t, OFF_OABS), DM, 2048, 2048, 2048, 0); }
            GSYNC_L();
        }
        norm_mod_phase<false>(WSP(bf16_t, OFF_XB), WSP(bf16_t, OFF_H), PA(norm_mlp_g) + li * DM, MODL(li, 3 * DM), MODL(li, 4 * DM), G, ldmap(lds));
        GSYNC_L();
        { pg8::EpiBf16<2> e{WSP(bf16_t, OFF_BIG), FF}; GEMM_RUN(pg8::EpiBf16<2>, e, WSP(bf16_t, OFF_H), WSP(bf16_t, OFF_W1T) + (size_t)li * DM * FF, FF, DM, DM, DM, 0); }
        GSYNC_L();
        { pg8::EpiRes<false> e{WSP(bf16_t, OFF_XB), WSP(bf16_t, OFF_XB), MODL(li, 5 * DM), nullptr}; GEMM_RUN_X(pg8::EpiRes<false>, e, WSP(bf16_t, OFF_BIG), WSP(bf16_t, OFF_W2T) + (size_t)li * DM * FF, DM, FF, FF, FF, 0, 8); }
        GSYNC_L();
}

__global__ void __launch_bounds__(NTHREADS, 2) fwd_megakernel(Params p) {
    extern __shared__ __attribute__((aligned(16))) unsigned char lds_raw[];
    LAS unsigned char* lds = (LAS unsigned char*)lds_raw;
    cg::grid_group grid = cg::this_grid();
    const int G = gridDim.x;
    const int tid0 = fresh_tid();
    if (tid0 < 64) ((LAS unsigned*)(lds + 131072))[tid0] = 0u;
    if (blockIdx.x == 0) { unsigned* bw = WSP(unsigned, OFF_BAR); for (int i = tid0; i < XCD_BAR_WORDS; i += NTHREADS) bw[i] = 0u; }
    __syncthreads();
    prologue(lds, G);
    grid.sync();
    { volatile LAS unsigned* st = (volatile LAS unsigned*)(lds + 131072 + 64); unsigned* bar = WSP(unsigned, OFF_BAR);
      if (threadIdx.x == 0) { const unsigned x = xb_xcc_id(); st[3] = x; st[4] = xb_add(bar + XB_XCNT(x), 1u); }
      xcd_barrier(bar, st, false);
      if (threadIdx.x == 0) { bool ok = (G == 256) && st[1] == 8u && st[3] < 8u;
#pragma unroll
          for (unsigned j = 0; j < 8; ++j) ok = ok && (xb_ld(bar + XB_XCNT(j)) == 32u);
          st[2] = ok ? 1u : 0u; }
      __syncthreads(); }

    layer_phases<0>(lds, G);
    layer_phases<1>(lds, G);
    layer_phases<2>(lds, G);
    layer_phases<3>(lds, G);
    final_norm_phase(WSP(bf16_t, OFF_XB), PA(out), PA(final_g), G, ldmap(lds));
}

extern "C" void kernel_launch(void* const* d_in, const int* in_sizes, int n_in, void* d_out, int out_size, void* d_ws, size_t ws_size, hipStream_t stream) {
    static int grid = 0;
    if (grid == 0) {
        if (n_in != 24 || in_sizes[0] != M * DM || out_size != M * DM || ws_size < WS_NEED) { fprintf(stderr, "kernel_launch: unexpected shapes (n_in %d, in0 %d, out %d, ws %zu)\n", n_in, n_in > 0 ? in_sizes[0] : -1, out_size, ws_size); grid = -1; return; }
        int dev = 0, cus = 0, per_cu = 0;
        hipGetDevice(&dev); hipDeviceGetAttribute(&cus, hipDeviceAttributeMultiprocessorCount, dev);
        if (hipFuncSetAttribute((const void*)fwd_megakernel, hipFuncAttributeMaxDynamicSharedMemorySize, LDS_BYTES) != hipSuccess) { fprintf(stderr, "kernel_launch: hipFuncSetAttribute failed\n"); grid = -1; return; }
        if (hipOccupancyMaxActiveBlocksPerMultiprocessor(&per_cu, (const void*)fwd_megakernel, NTHREADS, LDS_BYTES) != hipSuccess || per_cu < 1) { fprintf(stderr, "kernel_launch: occupancy query says %d\n", per_cu); per_cu = 1; }
        (void)hipGetLastError();
        grid = cus * 1;
    }
    if (grid < 0) return;
    Params p{};
    p.x = (const float*)d_in[0]; p.c = (const float*)d_in[1]; p.pos = (const int*)d_in[2]; p.ada_w = (const float*)d_in[3]; p.ada_b = (const float*)d_in[4];
    p.norm_mix_g = (const float*)d_in[5]; p.norm_mlp_g = (const float*)d_in[6]; p.pool_w = (const float*)d_in[7]; p.pool_scale = (const float*)d_in[8];
    p.sgu_w_in = (const float*)d_in[9]; p.sgu_ln_g = (const float*)d_in[10]; p.sgu_ln_b = (const float*)d_in[11]; p.sgu_w_s = (const float*)d_in[12]; p.sgu_b_s = (const float*)d_in[13]; p.sgu_w_out = (const float*)d_in[14];
    p.mla_w_dq_dkv = (const float*)d_in[15]; p.mla_q_norm_g = (const float*)d_in[16]; p.mla_kv_norm_g = (const float*)d_in[17]; p.mla_w_uq = (const float*)d_in[18]; p.mla_w_ukv = (const float*)d_in[19]; p.mla_w_o = (const float*)d_in[20];
    p.mlp_w1 = (const float*)d_in[21]; p.mlp_w2 = (const float*)d_in[22]; p.final_g = (const float*)d_in[23];
    p.out = (float*)d_out; p.ws = (unsigned char*)d_ws;
    void* args[] = {&p};
    hipError_t e = hipLaunchCooperativeKernel((const void*)fwd_megakernel, dim3(grid), dim3(NTHREADS), args, LDS_BYTES, stream);
    if (e != hipSuccess) fprintf(stderr, "kernel_launch: cooperative launch failed: %s (grid %d)\n", hipGetErrorString(e), grid);
}
```
